# Optimizing an MI355X kernel written in HIP

```python
import math, functools
import jax, jax.numpy as jnp
from jax import lax
import numpy as np

D_MODEL = 2048
BATCH = 4
SEQ = 4096
DEPTH = 2

DN_HEADS = 8
DN_HEAD_DIM = 128
DN_WIDTH = DN_HEADS * DN_HEAD_DIM
DN_CONV = 4
DN_CHUNK = 64
SG_GROUPS = 8
SG_GROUP_DIM = 128
SG_WIDTH = SG_GROUPS * SG_GROUP_DIM
SG_CHUNK = 128
D_FF = 5632
FFN_CONV = 3
EPS = 1e-6

SPLIT_SIZES = (3 * DN_WIDTH, DN_WIDTH, DN_HEADS, DN_HEADS, SG_WIDTH, SG_WIDTH, D_MODEL, D_MODEL)
SPLIT_POINTS = tuple(int(s) for s in np.cumsum(SPLIT_SIZES)[:-1])
IN_COLS = int(sum(SPLIT_SIZES))

kernel_name = "hybrid_deltanet_gmlp_convffn_gated_merge"


def rmsnorm(x, g):
    xf = x.astype(jnp.float32)
    y = xf * lax.rsqrt(jnp.mean(xf * xf, axis=-1, keepdims=True) + EPS)
    return (y * g.astype(jnp.float32)).astype(x.dtype)


def layernorm(x, g, b):
    xf = x.astype(jnp.float32)
    mu = jnp.mean(xf, axis=-1, keepdims=True)
    xc = xf - mu
    y = xc * lax.rsqrt(jnp.mean(xc * xc, axis=-1, keepdims=True) + EPS)
    return (y * g.astype(jnp.float32) + b.astype(jnp.float32)).astype(x.dtype)


def l2norm(x):
    xf = x.astype(jnp.float32)
    return xf * lax.rsqrt(jnp.sum(xf * xf, axis=-1, keepdims=True) + EPS)


def causal_dwconv(x, w):
    K = w.shape[0]
    T = x.shape[1]
    xp = jnp.pad(x, ((0, 0), (K - 1, 0), (0, 0)))
    out = xp[:, 0:T] * w[0]
    for j in range(1, K):
        out = out + xp[:, j:j + T] * w[j]
    return out


def gated_delta_rule_chunked(q, k, v, g, beta):
    B, T, H, Dk = q.shape
    Dv = v.shape[-1]
    C = DN_CHUNK
    N = T // C

    def to_chunks(t):
        t = t.astype(jnp.float32).reshape((B, N, C, H) + t.shape[3:])
        return jnp.moveaxis(t, 3, 1)

    q = to_chunks(q) * (Dk ** -0.5)
    k = to_chunks(k)
    v = to_chunks(v)
    g = jnp.cumsum(to_chunks(g), axis=-1)
    beta = to_chunks(beta)
    k_beta = k * beta[..., None]
    v_beta = v * beta[..., None]

    causal = jnp.tril(jnp.ones((C, C), dtype=bool))
    strict = jnp.tril(jnp.ones((C, C), dtype=bool), -1)
    decay = jnp.exp(jnp.where(causal, g[..., :, None] - g[..., None, :], -jnp.inf))

    L = jnp.where(strict, jnp.einsum('bhnid,bhnjd->bhnij', k_beta, k) * decay, 0.0)
    eye = jnp.eye(C, dtype=jnp.float32)
    Tinv = lax.linalg.triangular_solve(L + eye, jnp.broadcast_to(eye, L.shape),
                                       left_side=True, lower=True, unit_diagonal=True)
    u = jnp.einsum('bhnij,bhnjv->bhniv', Tinv, v_beta)
    w = jnp.einsum('bhnij,bhnjk->bhnik', Tinv, k_beta * jnp.exp(g)[..., None])

    attn = jnp.where(causal, jnp.einsum('bhnid,bhnjd->bhnij', q, k) * decay, 0.0)
    q_dec = q * jnp.exp(g)[..., None]
    g_last = g[..., -1]
    k_dec = k * jnp.exp(g_last[..., None] - g)[..., None]

    xs = tuple(jnp.moveaxis(t, 2, 0) for t in (u, w, attn, q_dec, k_dec, g_last))

    def step(S, inp):
        u_n, w_n, a_n, qd_n, kd_n, gl_n = inp
        v_new = u_n - jnp.einsum('bhck,bhkv->bhcv', w_n, S)
        o_n = (jnp.einsum('bhck,bhkv->bhcv', qd_n, S)
               + jnp.einsum('bhij,bhjv->bhiv', a_n, v_new))
        S = S * jnp.exp(gl_n)[..., None, None] + jnp.einsum('bhck,bhcv->bhkv', kd_n, v_new)
        return S, o_n

    S0 = jnp.zeros((B, H, Dk, Dv), jnp.float32)
    _, o = lax.scan(step, S0, xs)
    return jnp.transpose(o, (1, 0, 3, 2, 4)).reshape(B, T, H, Dv)


def setup_inputs(seed: int = 0) -> dict:
    key = jax.random.key(seed)
    ks = jax.random.split(key, 24)
    f32 = jnp.float32

    def nrm(k, shape, scale):
        return jax.random.normal(k, shape, f32) * scale

    x = jax.random.normal(ks[0], (BATCH, SEQ, D_MODEL), f32)
    norm1_g = 1.0 + nrm(ks[1], (DEPTH, D_MODEL), 0.02)
    w_in = nrm(ks[2], (DEPTH, D_MODEL, IN_COLS), D_MODEL ** -0.5)
    dn_conv_w = nrm(ks[3], (DEPTH, DN_CONV, 3 * DN_WIDTH), DN_CONV ** -0.5)
    dn_a_log = jnp.log(jax.random.uniform(ks[4], (DEPTH, DN_HEADS), f32, 1.0, 16.0))
    dt = jnp.exp(jax.random.uniform(ks[5], (DEPTH, DN_HEADS), f32,
                                    math.log(0.001), math.log(0.1)))
    dn_dt_bias = dt + jnp.log(-jnp.expm1(-dt))
    dn_onorm_g = 1.0 + nrm(ks[6], (DEPTH, DN_HEAD_DIM), 0.02)
    sg_ln_g = 1.0 + nrm(ks[7], (DEPTH, SG_WIDTH), 0.02)
    sg_ln_b = nrm(ks[8], (DEPTH, SG_WIDTH), 0.02)
    sg_w = nrm(ks[9], (DEPTH, SG_GROUPS, SG_CHUNK, SG_CHUNK), 0.5 * SG_CHUNK ** -0.5)
    sg_b = 1.0 + nrm(ks[10], (DEPTH, SG_GROUPS, SG_CHUNK), 0.02)
    w_branch_a = nrm(ks[11], (DEPTH, DN_WIDTH, D_MODEL), DN_WIDTH ** -0.5)
    w_branch_b = nrm(ks[12], (DEPTH, SG_WIDTH, D_MODEL), SG_WIDTH ** -0.5)
    w_out = nrm(ks[13], (DEPTH, D_MODEL, D_MODEL), D_MODEL ** -0.5)
    norm2_g = 1.0 + nrm(ks[14], (DEPTH, D_MODEL), 0.02)
    ffn_w_gate = nrm(ks[15], (DEPTH, D_MODEL, D_FF), D_MODEL ** -0.5)
    ffn_w_up = nrm(ks[16], (DEPTH, D_MODEL, D_FF), D_MODEL ** -0.5)
    ffn_conv_w = nrm(ks[17], (DEPTH, FFN_CONV, D_FF), FFN_CONV ** -0.5)
    ffn_conv_b = nrm(ks[18], (DEPTH, D_FF), 0.02)
    ffn_w_down = nrm(ks[19], (DEPTH, D_FF, D_MODEL), D_FF ** -0.5)
    final_norm_g = 1.0 + nrm(ks[20], (D_MODEL,), 0.02)
    return {"x": x, "norm1_g": norm1_g, "w_in": w_in, "dn_conv_w": dn_conv_w,
            "dn_a_log": dn_a_log, "dn_dt_bias": dn_dt_bias, "dn_onorm_g": dn_onorm_g,
            "sg_ln_g": sg_ln_g, "sg_ln_b": sg_ln_b, "sg_w": sg_w, "sg_b": sg_b,
            "w_branch_a": w_branch_a, "w_branch_b": w_branch_b, "w_out": w_out,
            "norm2_g": norm2_g, "ffn_w_gate": ffn_w_gate, "ffn_w_up": ffn_w_up,
            "ffn_conv_w": ffn_conv_w, "ffn_conv_b": ffn_conv_b, "ffn_w_down": ffn_w_down,
            "final_norm_g": final_norm_g}


def reference(x, norm1_g, w_in, dn_conv_w, dn_a_log, dn_dt_bias, dn_onorm_g,
              sg_ln_g, sg_ln_b, sg_w, sg_b, w_branch_a, w_branch_b, w_out,
              norm2_g, ffn_w_gate, ffn_w_up, ffn_conv_w, ffn_conv_b, ffn_w_down,
              final_norm_g):
    B, T, _ = x.shape
    sg_mask = jnp.tril(jnp.ones((SG_CHUNK, SG_CHUNK), dtype=bool))
    for l in range(DEPTH):
        h = rmsnorm(x, norm1_g[l])
        proj = h @ w_in[l]
        qkv, z, b_raw, a_raw, u_raw, v_raw, ga_raw, gb_raw = jnp.split(proj, SPLIT_POINTS, axis=-1)

        qkv = jax.nn.silu(causal_dwconv(qkv, dn_conv_w[l]))
        q, k, v = jnp.split(qkv, 3, axis=-1)
        q = l2norm(q.reshape(B, T, DN_HEADS, DN_HEAD_DIM))
        k = l2norm(k.reshape(B, T, DN_HEADS, DN_HEAD_DIM))
        v = v.reshape(B, T, DN_HEADS, DN_HEAD_DIM)
        beta = jax.nn.sigmoid(b_raw.astype(jnp.float32))
        g = -jnp.exp(dn_a_log[l].astype(jnp.float32)) * jax.nn.softplus(
            a_raw.astype(jnp.float32) + dn_dt_bias[l].astype(jnp.float32))
        o = gated_delta_rule_chunked(q, k, v, g, beta)
        o = rmsnorm(o, dn_onorm_g[l]) * jax.nn.silu(
            z.reshape(B, T, DN_HEADS, DN_HEAD_DIM).astype(jnp.float32))
        y_a = o.reshape(B, T, DN_WIDTH).astype(x.dtype)

        u = jax.nn.gelu(u_raw, approximate=False)
        vg = layernorm(jax.nn.gelu(v_raw, approximate=False), sg_ln_g[l], sg_ln_b[l])
        vg = vg.reshape(B, T // SG_CHUNK, SG_CHUNK, SG_GROUPS, SG_GROUP_DIM)
        ws = jnp.where(sg_mask, sg_w[l], 0.0)
        mixed = (jnp.einsum('gij,bnjgc->bnigc', ws, vg)
                 + jnp.transpose(sg_b[l])[None, None, :, :, None])
        y_b = u * mixed.reshape(B, T, SG_WIDTH)

        merged = (jax.nn.sigmoid(ga_raw) * (y_a @ w_branch_a[l])
                  + jax.nn.sigmoid(gb_raw) * (y_b @ w_branch_b[l]))
        x = x + merged @ w_out[l]

        h2 = rmsnorm(x, norm2_g[l])
        gate = causal_dwconv(h2 @ ffn_w_gate[l], ffn_conv_w[l]) + ffn_conv_b[l]
        x = x + (jax.nn.silu(gate) * (h2 @ ffn_w_up[l])) @ ffn_w_down[l]
    return rmsnorm(x, final_norm_g)
```

```cpp
#include <hip/hip_runtime.h>
#include <hip/hip_cooperative_groups.h>
#include <cstdio>
namespace cg = cooperative_groups;
__device__ __forceinline__ int fresh_tid() { int t = threadIdx.x; asm volatile("" : "+v"(t)); return t; }
namespace pg8 {
#define PG8_LAS __attribute__((address_space(3)))
typedef unsigned short bf16_t;
typedef short bf16x8 __attribute__((ext_vector_type(8)));
typedef float f32x4 __attribute__((ext_vector_type(4)));
typedef unsigned u32x4 __attribute__((ext_vector_type(4)));
constexpr int BM = 256, BK = 64, HALF = 128, HTB = HALF * BK * 2  , STAGE_BYTES = 8 * HTB, NXCD = 8, WGM = 8;

__host__ __device__ __forceinline__ int lds_byte(int r, int c) { const int st = (r >> 4) * 2 + (c >> 5), rr = r & 15, cc = c & 31, ob = rr * 64 + cc * 2; return st * 1024 + (ob ^ (((ob >> 9) & 1) << 5)); }
__host__ __device__ __forceinline__ void stage_rc(int b, int& R, int& C) { const int st = b / 1024, sb = b % 1024, swz = sb ^ (((sb >> 9) & 1) << 5); R = (st >> 1) * 16 + swz / 64; C = (st & 1) * 32 + (swz % 64) / 2; }
__host__ __device__ __forceinline__ int perm32(int rho) { const int n = rho >> 4, i = rho & 15; return 8 * (i >> 2) + 4 * n + (i & 3); }

struct Unit { int pm, pn; };
struct Gemm { const bf16_t* A; const bf16_t* Bt; int M, N, K; };

struct StaticOrder {
    int nM, nN, nwg, G, c;
    __host__ __device__ void init(int M, int N, int G_, int c_) { nM = M / BM; nN = N / BM; nwg = nM * nN; G = G_; c = c_; }
    __host__ __device__ bool next(int i, Unit& u) const {
        const long L = (long)i * G + c; if (L >= nwg) return false;
        int wgid = (int)L; { const int q = nwg / NXCD, r = nwg % NXCD, xcd = wgid % NXCD, off = wgid / NXCD; wgid = (xcd < r ? xcd * (q + 1) : r * (q + 1) + (xcd - r) * q) + off; }
        const int nig = WGM * nN, gid = wgid / nig, fm = gid * WGM, gsz = (nM - fm) < WGM ? (nM - fm) : WGM;
        u.pm = fm + ((wgid % nig) % gsz); u.pn = (wgid % nig) / gsz; return true;
    }
    __device__ __forceinline__ void a_ready(const Unit&) const {}
    __device__ __forceinline__ void done(const Unit&) const {}
};
__device__ __forceinline__ unsigned cvt_pk_bf16(float lo, float hi) { unsigned r; asm volatile("v_cvt_pk_bf16_f32 %0, %1, %2" : "=v"(r) : "v"(lo), "v"(hi)); return r; }
typedef float f32x2 __attribute__((ext_vector_type(2)));
__device__ __forceinline__ f32x2 gelu_pk(f32x2 v) {
    const f32x2 av = __builtin_elementwise_abs(v), d = av * 0.2316418882f + 1.0f;
    f32x2 t; t.x = __builtin_amdgcn_rcpf(d.x); t.y = __builtin_amdgcn_rcpf(d.y);
    f32x2 q = t * 0.5307027145f + (-0.7265760135f); q = q * t + 0.7107068705f; q = q * t + (-0.142248368f); q = q * t + 0.127414796f; q = q * t;
    const f32x2 s = (v * v) * (-0.72134752044f);
    f32x2 e; e.x = __builtin_amdgcn_exp2f(s.x); e.y = __builtin_amdgcn_exp2f(s.y);
    const f32x2 m = v * (q * e), r = v - m;
    f32x2 o; o.x = v.x < 0.f ? m.x : r.x; o.y = v.y < 0.f ? m.y : r.y; return o;
}

struct EpiF32 {
    static constexpr bool PERM = false, AFTER_DRAIN = false;
    float* C; int ldc; const float* bias;
    __device__ __forceinline__ void operator()(const f32x4 (&acc)[2][2][4][2], const Unit& u, int wr, int wc, int fr, int fq) const {
        const int row0 = u.pm * BM + wr * 64 + fr, col0 = u.pn * BM + wc * 32 + 4 * fq;
        f32x4 bv[2][2];
#pragma unroll
        for (int bj = 0; bj < 2; ++bj)
#pragma unroll
            for (int n = 0; n < 2; ++n) bv[bj][n] = bias ? *(const f32x4*)(bias + col0 + bj * HALF + n * 16) : (f32x4){0.f, 0.f, 0.f, 0.f};
#pragma unroll
        for (int ai = 0; ai < 2; ++ai)
#pragma unroll
            for (int m = 0; m < 4; ++m) { float* rowp = C + (size_t)(row0 + ai * HALF + m * 16) * ldc + col0;
#pragma unroll
                for (int bj = 0; bj < 2; ++bj)
#pragma unroll
                    for (int n = 0; n < 2; ++n) *(f32x4*)(rowp + bj * HALF + n * 16) = acc[ai][bj][m][n] + bv[bj][n]; }
    }
};
template <int ACT  > struct EpiBf16 {
    static constexpr bool PERM = true, AFTER_DRAIN = false;
    bf16_t* O; int ldc; const float* bias; int split_cols; size_t split_stride;
    __device__ __forceinline__ void operator()(const f32x4 (&acc)[2][2][4][2], const Unit& u, int wr, int wc, int fr, int fq) const {
        const int row0 = u.pm * BM + wr * 64 + fr; int colt = u.pn * BM; bf16_t* base = O;
        if (split_cols) { const int t = colt / split_cols; base += (size_t)t * split_stride; colt -= t * split_cols; }
        const int col0 = colt + wc * 32 + 8 * fq, bcol0 = u.pn * BM + wc * 32 + 8 * fq;
        f32x4 bv[2][2];
#pragma unroll
        for (int bj = 0; bj < 2; ++bj)
#pragma unroll
            for (int n = 0; n < 2; ++n) bv[bj][n] = bias ? *(const f32x4*)(bias + bcol0 + bj * HALF + 4 * n) : (f32x4){0.f, 0.f, 0.f, 0.f};
#pragma unroll
        for (int ai = 0; ai < 2; ++ai)
#pragma unroll
            for (int m = 0; m < 4; ++m) { bf16_t* rowp = base + (size_t)(row0 + ai * HALF + m * 16) * ldc + col0;
#pragma unroll
                for (int bj = 0; bj < 2; ++bj) { f32x4 v0 = acc[ai][bj][m][0] + bv[bj][0], v1 = acc[ai][bj][m][1] + bv[bj][1];
                    if (ACT == 1) { f32x2 a = gelu_pk((f32x2){v0[0], v0[1]}), b = gelu_pk((f32x2){v0[2], v0[3]}), c = gelu_pk((f32x2){v1[0], v1[1]}), d = gelu_pk((f32x2){v1[2], v1[3]});
                        v0 = (f32x4){a.x, a.y, b.x, b.y}; v1 = (f32x4){c.x, c.y, d.x, d.y}; }
                    if (ACT == 2) {
#pragma unroll
                        for (int j = 0; j < 4; ++j) { v0[j] = 0.5f * v0[j] * (1.0f + erff(v0[j] * 0.70710678f)); v1[j] = 0.5f * v1[j] * (1.0f + erff(v1[j] * 0.70710678f)); } }
                    u32x4 w; w.x = cvt_pk_bf16(v0[0], v0[1]); w.y = cvt_pk_bf16(v0[2], v0[3]); w.z = cvt_pk_bf16(v1[0], v1[1]); w.w = cvt_pk_bf16(v1[2], v1[3]);
                    *(u32x4*)(rowp + bj * HALF) = w; } }
    }
};
template <class Epi, class Sched, bool STAMP = false>
__device__ __forceinline__ void gemm_phase(PG8_LAS unsigned char* lds, const Gemm g, const Sched& S, const Epi& E, unsigned long long* stamps) {
    const int tid = fresh_tid(), wid = __builtin_amdgcn_readfirstlane(tid >> 6), lane = tid & 63, wr = wid >> 2, wc = wid & 3, fr = lane & 15, fq = lane >> 4;
    const int K = g.K, nt = K / BK;
    int ts_lo = 0, ts_hi = 0, nts = 0; const unsigned long long rt_entry = STAMP ? (unsigned long long)wall_clock64() : 0ull;
#define PG8_STAMP() do { if (STAMP && wid == 0 && nts < 64) { const unsigned long long _c = (unsigned long long)clock64(); \
        ts_lo = (lane == nts) ? (int)(unsigned)_c : ts_lo; ts_hi = (lane == nts) ? (int)(unsigned)(_c >> 32) : ts_hi; ++nts; } } while (0)
    PG8_STAMP();
    unsigned voffA[2], voffB[2];
#pragma unroll
    for (int i = 0; i < 2; ++i) { int R, C; stage_rc(tid * 16 + i * 8192, R, C); const int Rb = Epi::PERM ? ((R & ~31) + perm32(R & 31)) : R;
        voffA[i] = (unsigned)(R * K + C) * 2u; voffB[i] = (unsigned)(Rb * K + C) * 2u; }
    const size_t kstep = (size_t)(BK * 2);
    const size_t hstep = (size_t)HALF * K * 2;
    const size_t tstep = 2 * hstep;
    const unsigned ldsw = (unsigned)wid * 1024u;
    const int aoff = lds_byte(wr * 64 + fr, fq * 8), boff = lds_byte(wc * 32 + fr, fq * 8);
#define PG8_SA(b, h) (((b) * 2 + (h)) * HTB)
#define PG8_SB(b, h) ((4 + (b) * 2 + (h)) * HTB)
#define PG8_STAGE(bufoff, gbase, voff) do { _Pragma("unroll") for (int _i = 0; _i < 2; ++_i) \
        __builtin_amdgcn_global_load_lds((const unsigned*)((const char*)(gbase) + (voff)[_i]), (PG8_LAS unsigned*)(lds + (bufoff) + ldsw + _i * 8192), 16, 0, 0); } while (0)
#define PG8_LDA(dst, b, h) do { _Pragma("unroll") for (int m = 0; m < 4; ++m) _Pragma("unroll") for (int k = 0; k < 2; ++k) dst[m][k] = *(const PG8_LAS bf16x8*)(lds + PG8_SA(b, h) + aoff + m * 2048 + k * 1024); } while (0)
#define PG8_LDB(dst, b, h) do { _Pragma("unroll") for (int n = 0; n < 2; ++n) _Pragma("unroll") for (int k = 0; k < 2; ++k) dst[n][k] = *(const PG8_LAS bf16x8*)(lds + PG8_SB(b, h) + boff + n * 2048 + k * 1024); } while (0)
#define PG8_MMA(ai, bj, At, Bt) do { __builtin_amdgcn_s_setprio(1); _Pragma("unroll") for (int m = 0; m < 4; ++m) _Pragma("unroll") for (int n = 0; n < 2; ++n) _Pragma("unroll") for (int k = 0; k < 2; ++k) \
        acc[ai][bj][m][n] = __builtin_amdgcn_mfma_f32_16x16x32_bf16(Bt[n][k], At[m][k], acc[ai][bj][m][n], 0, 0, 0); __builtin_amdgcn_s_setprio(0); } while (0)
#define PG8_WAIT_V(n) asm volatile("s_waitcnt vmcnt(" #n ")" ::: "memory")
#define PG8_WAIT_L(n) asm volatile("s_waitcnt lgkmcnt(" #n ")" ::: "memory")
#define PG8_BAR __builtin_amdgcn_s_barrier()
#define PG8_SCHED __builtin_amdgcn_sched_barrier(0)
    Unit cur, nxt; int ui = 0;
    if (!S.next(0, cur)) return;
    f32x4 acc[2][2][4][2];
#pragma unroll
    for (int a = 0; a < 2; ++a)
#pragma unroll
        for (int b = 0; b < 2; ++b)
#pragma unroll
            for (int m = 0; m < 4; ++m)
#pragma unroll
                for (int n = 0; n < 2; ++n) acc[a][b][m][n] = (f32x4){0.f, 0.f, 0.f, 0.f};
    bf16x8 At[4][2], B0[2][2], B1[2][2];
    const char* cA = (const char*)g.A + (size_t)cur.pm * tstep; const char* cB = (const char*)g.Bt + (size_t)cur.pn * tstep;
    S.a_ready(cur);
    PG8_STAGE(PG8_SB(0, 0), cB, voffB); PG8_STAGE(PG8_SA(0, 0), cA, voffA); PG8_STAGE(PG8_SB(0, 1), cB + hstep, voffB); PG8_STAGE(PG8_SA(0, 1), cA + hstep, voffA);
    if (wr == 1) PG8_BAR;
    PG8_WAIT_V(4); PG8_BAR;
    PG8_STAGE(PG8_SB(1, 0), cB + kstep, voffB); PG8_STAGE(PG8_SA(1, 0), cA + kstep, voffA); PG8_STAGE(PG8_SB(1, 1), cB + hstep + kstep, voffB);
    PG8_WAIT_V(6); PG8_BAR;
    PG8_STAMP();
    for (;;) {
        const bool has_next = S.next(ui + 1, nxt);
        const char* nA = has_next ? (const char*)g.A + (size_t)nxt.pm * tstep : cA; const char* nB = has_next ? (const char*)g.Bt + (size_t)nxt.pn * tstep : cB;
        for (int t = 0; t < nt; t += 2) {
            const bool last = (t == nt - 2);
            const char* a1 = cA + (size_t)(t + 1) * kstep;
            const char* a2 = last ? nA : cA + (size_t)(t + 2) * kstep; const char* b2 = last ? nB : cB + (size_t)(t + 2) * kstep;
            const char* a3 = a2 + kstep; const char* b3 = b2 + kstep;
            if (last && has_next) S.a_ready(nxt);
            PG8_LDB(B0, 0, 0); PG8_SCHED; PG8_LDA(At, 0, 0); PG8_STAGE(PG8_SA(1, 1), a1 + hstep, voffA);
            PG8_WAIT_L(8); PG8_BAR; PG8_WAIT_L(0); PG8_MMA(0, 0, At, B0); PG8_BAR; PG8_SCHED;
            PG8_LDB(B1, 0, 1); PG8_STAGE(PG8_SB(0, 0), b2, voffB);
            PG8_BAR; PG8_WAIT_L(0); PG8_MMA(0, 1, At, B1); PG8_BAR;
            PG8_LDA(At, 0, 1); PG8_STAGE(PG8_SA(0, 0), a2, voffA);
            PG8_BAR; PG8_WAIT_L(0); PG8_MMA(1, 0, At, B0); PG8_BAR; PG8_SCHED;
            PG8_STAGE(PG8_SB(0, 1), b2 + hstep, voffB);
            PG8_WAIT_V(6); PG8_BAR; PG8_MMA(1, 1, At, B1); PG8_BAR;
            PG8_LDB(B0, 1, 0); PG8_SCHED; PG8_LDA(At, 1, 0); PG8_STAGE(PG8_SA(0, 1), a2 + hstep, voffA);
            PG8_WAIT_L(8); PG8_BAR; PG8_WAIT_L(0); PG8_MMA(0, 0, At, B0); PG8_BAR; PG8_SCHED;
            PG8_LDB(B1, 1, 1); PG8_STAGE(PG8_SB(1, 0), b3, voffB);
            PG8_BAR; PG8_WAIT_L(0); PG8_MMA(0, 1, At, B1); PG8_BAR;
            PG8_LDA(At, 1, 1); PG8_STAGE(PG8_SA(1, 0), a3, voffA);
            PG8_BAR; PG8_WAIT_L(0); PG8_MMA(1, 0, At, B0); PG8_BAR; PG8_SCHED;
            PG8_STAGE(PG8_SB(1, 1), b3 + hstep, voffB);
            PG8_WAIT_V(6); PG8_BAR; PG8_MMA(1, 1, At, B1); PG8_BAR;
        }
        PG8_STAMP();
        if constexpr (!Epi::AFTER_DRAIN) { E(acc, cur, wr, wc, fr, fq); S.done(cur); }
        PG8_STAMP();
        if (!has_next) break;
#pragma unroll
        for (int a = 0; a < 2; ++a)
#pragma unroll
            for (int b = 0; b < 2; ++b)
#pragma unroll
                for (int m = 0; m < 4; ++m)
#pragma unroll
                    for (int n = 0; n < 2; ++n) acc[a][b][m][n] = (f32x4){0.f, 0.f, 0.f, 0.f};
        cur = nxt; cA = nA; cB = nB; ++ui;
    }
    PG8_WAIT_V(0);
    if (wr == 0) PG8_BAR;
    PG8_BAR;
    if constexpr (Epi::AFTER_DRAIN) { E.fused(acc, cur, wr, wc, fr, fq, lds, wid, lane); S.done(cur); }
    PG8_STAMP();
    if (STAMP && wid == 0) { stamps[lane] = lane < nts ? (((unsigned long long)(unsigned)ts_hi << 32) | (unsigned)ts_lo) : 0ull;
        if (lane == 62) stamps[62] = rt_entry; if (lane == 63) stamps[63] = (unsigned long long)wall_clock64(); }
#undef PG8_STAMP
#undef PG8_SA
#undef PG8_SB
#undef PG8_STAGE
#undef PG8_LDA
#undef PG8_LDB
#undef PG8_MMA
#undef PG8_WAIT_V
#undef PG8_WAIT_L
#undef PG8_BAR
#undef PG8_SCHED
}
}

namespace mk {
#define LAS __attribute__((address_space(3)))
using pg8::bf16_t; using pg8::bf16x8; using pg8::f32x4; using pg8::u32x4;
typedef unsigned u32x2 __attribute__((ext_vector_type(2)));

constexpr int NTOK = 16384, DM = 2048, SEQ = 4096, NIN = 10240, INC = 10256, FF = 5632, NL = 2;
constexpr size_t MiB = (size_t)1 << 20;
constexpr size_t SPL = (size_t)NTOK * 1024;
constexpr size_t WS_WA = 0, WS_WB = 4 * MiB, WS_WOUT = 8 * MiB, WS_WGU = 16 * MiB, WS_WD = 60 * MiB;
constexpr size_t WS_WIN = 82 * MiB;
constexpr size_t WS_ATTN = 82 * MiB, WS_GL = 98 * MiB;
constexpr size_t WS_H = 122 * MiB;
constexpr size_t WS_YB = 122 * MiB, WS_O = 154 * MiB;
constexpr size_t WS_PROJ = 186 * MiB;
constexpr size_t WS_YA = 186 * MiB;
constexpr size_t WS_MRG = 218 * MiB;
constexpr size_t WS_BETA = 506 * MiB, WS_G = 506 * MiB + 512 * 1024;
constexpr size_t WS_WF = 507 * MiB, WS_QDF = 539 * MiB, WS_KDF = 571 * MiB, WS_UF = 603 * MiB;
constexpr size_t WS_TMP = 507 * MiB;
constexpr size_t WS_H2 = 577 * MiB;
constexpr size_t WS_GU = 82 * MiB;
constexpr size_t WS_HID = 434 * MiB;
constexpr size_t WS_END = 641 * MiB;
constexpr int LDS_BYTES = 150 * 1024;

struct Params { const float* in[21]; float* out; unsigned char* ws; int ph_lo, ph_hi, dbg, pad; };
typedef const Params __attribute__((address_space(4)))* KP;
__device__ __forceinline__ KP get_kp() { KP k = (KP)__builtin_amdgcn_kernarg_segment_ptr(); asm volatile("" : "+s"(k)); return k; }
__device__ __forceinline__ int launder_i(int v) { asm volatile("" : "+s"(v)); return v; }

__device__ __forceinline__ float bflo(unsigned u) { return __uint_as_float(u << 16); }
__device__ __forceinline__ float bfhi(unsigned u) { return __uint_as_float(u & 0xffff0000u); }
__device__ __forceinline__ float bf2f(bf16_t b) { return __uint_as_float(((unsigned)b) << 16); }
typedef __bf16 bf2_t __attribute__((ext_vector_type(2)));
typedef float f2_t __attribute__((ext_vector_type(2)));
__device__ __forceinline__ unsigned pk(float lo, float hi) { f2_t v = {lo, hi}; bf2_t r = __builtin_convertvector(v, bf2_t); return __builtin_bit_cast(unsigned, r); }
__device__ __forceinline__ float silu_f(float x) { return x / (1.f + __expf(-x)); }
__device__ __forceinline__ float sigm_f(float x) { return 1.f / (1.f + __expf(-x)); }
__device__ __forceinline__ float gelu_f(float x) { return 0.5f * x * (1.f + erff(x * 0.70710678118654752f)); }
__device__ __forceinline__ float wave_sum(float v) {
#pragma unroll
    for (int o = 32; o >= 1; o >>= 1) v += __shfl_xor(v, o);
    return v;
}
__device__ __forceinline__ bf16x8 pack8(const float (&v)[8]) {
    u32x4 w; w.x = pk(v[0], v[1]); w.y = pk(v[2], v[3]); w.z = pk(v[4], v[5]); w.w = pk(v[6], v[7]);
    return __builtin_bit_cast(bf16x8, w);
}
__device__ __forceinline__ bf16x8 pack44(f32x4 a, f32x4 b) {
    u32x4 w; w.x = pk(a[0], a[1]); w.y = pk(a[2], a[3]); w.z = pk(b[0], b[1]); w.w = pk(b[2], b[3]);
    return __builtin_bit_cast(bf16x8, w);
}
#define MFMA(a, b, c) __builtin_amdgcn_mfma_f32_16x16x32_bf16((a), (b), (c), 0, 0, 0)
#define LDS_FENCE() asm volatile("s_waitcnt lgkmcnt(0)" ::: "memory")

struct EpiRes {
    static constexpr bool PERM = false, AFTER_DRAIN = false;
    const float* base; float* out;
    __device__ __forceinline__ void operator()(const f32x4 (&acc)[2][2][4][2], const pg8::Unit& u, int wr, int wc, int fr, int fq) const {
        const int row0 = u.pm * 256 + wr * 64 + fr, col0 = u.pn * 256 + wc * 32 + 4 * fq;
#pragma unroll
        for (int ai = 0; ai < 2; ++ai)
#pragma unroll
            for (int m = 0; m < 4; ++m) { const size_t off = (size_t)(row0 + ai * 128 + m * 16) * DM + col0;
#pragma unroll
                for (int bj = 0; bj < 2; ++bj)
#pragma unroll
                    for (int n = 0; n < 2; ++n) { const f32x4 b = *(const f32x4*)(base + off + bj * 128 + n * 16); *(f32x4*)(out + off + bj * 128 + n * 16) = b + acc[ai][bj][m][n]; }
                asm volatile("" ::: "memory"); }
    }
};
struct EpiGateA {
    static constexpr bool PERM = false, AFTER_DRAIN = false;
    float* tmp; const bf16_t* gate;
    __device__ __forceinline__ void operator()(const f32x4 (&acc)[2][2][4][2], const pg8::Unit& u, int wr, int wc, int fr, int fq) const {
        const int row0 = u.pm * 256 + wr * 64 + fr, col0 = u.pn * 256 + wc * 32 + 4 * fq;
        const bf16_t* gb = gate + (size_t)(col0 >> 10) * SPL + (col0 & 1023);
#pragma unroll
        for (int ai = 0; ai < 2; ++ai)
#pragma unroll
            for (int m = 0; m < 4; ++m) { const int row = row0 + ai * 128 + m * 16;
#pragma unroll
                for (int bj = 0; bj < 2; ++bj)
#pragma unroll
                    for (int n = 0; n < 2; ++n) { const u32x2 gv = *(const u32x2*)(gb + (size_t)row * 1024 + bj * 128 + n * 16);
                        f32x4 s; s[0] = sigm_f(bflo(gv.x)); s[1] = sigm_f(bfhi(gv.x)); s[2] = sigm_f(bflo(gv.y)); s[3] = sigm_f(bfhi(gv.y));
                        *(f32x4*)(tmp + (size_t)row * DM + col0 + bj * 128 + n * 16) = s * acc[ai][bj][m][n]; }
                asm volatile("" ::: "memory"); }
    }
};
struct EpiGateB {
    static constexpr bool PERM = false, AFTER_DRAIN = false;
    const float* tmp; const bf16_t* gate; bf16_t* mrg;
    __device__ __forceinline__ void operator()(const f32x4 (&acc)[2][2][4][2], const pg8::Unit& u, int wr, int wc, int fr, int fq) const {
        const int row0 = u.pm * 256 + wr * 64 + fr, col0 = u.pn * 256 + wc * 32 + 4 * fq;
        const bf16_t* gb = gate + (size_t)(col0 >> 10) * SPL + (col0 & 1023);
#pragma unroll
        for (int ai = 0; ai < 2; ++ai)
#pragma unroll
            for (int m = 0; m < 4; ++m) { const int row = row0 + ai * 128 + m * 16;
#pragma unroll
                for (int bj = 0; bj < 2; ++bj)
#pragma unroll
                    for (int n = 0; n < 2; ++n) { const u32x2 gv = *(const u32x2*)(gb + (size_t)row * 1024 + bj * 128 + n * 16);
                        const f32x4 t = *(const f32x4*)(tmp + (size_t)row * DM + col0 + bj * 128 + n * 16);
                        f32x4 s; s[0] = sigm_f(bflo(gv.x)); s[1] = sigm_f(bfhi(gv.x)); s[2] = sigm_f(bflo(gv.y)); s[3] = sigm_f(bfhi(gv.y));
                        const f32x4 r = t + s * acc[ai][bj][m][n];
                        u32x2 w; w.x = pk(r[0], r[1]); w.y = pk(r[2], r[3]);
                        *(u32x2*)(mrg + (size_t)row * DM + col0 + bj * 128 + n * 16) = w; }
                asm volatile("" ::: "memory"); }
    }
};

__device__ __forceinline__ void xpose_phase(KP p, int l, LAS float* tile) {
    const int tid = fresh_tid(), G = gridDim.x;
    unsigned char* ws = p->ws;
    constexpr int T_IN = 32 * 160, T_A = 16 * 32, T_OUT = 32 * 32, T_GU = 32 * 176, T_D = 88 * 32, T_ALL = T_IN + 2 * T_A + T_OUT + T_GU + T_D;
    for (int t = blockIdx.x; t < T_ALL; t += G) {
        int u = t; const float* src; int ld, K, nct; bf16_t* dst; int kind;
        if (u < T_IN) { kind = 0; src = p->in[2] + (size_t)l * DM * INC; ld = INC; K = DM; nct = 160; dst = (bf16_t*)(ws + WS_WIN); }
        else if ((u -= T_IN) < T_A) { kind = 1; src = p->in[11] + (size_t)l * 1024 * DM; ld = DM; K = 1024; nct = 32; dst = (bf16_t*)(ws + WS_WA); }
        else if ((u -= T_A) < T_A) { kind = 1; src = p->in[12] + (size_t)l * 1024 * DM; ld = DM; K = 1024; nct = 32; dst = (bf16_t*)(ws + WS_WB); }
        else if ((u -= T_A) < T_OUT) { kind = 1; src = p->in[13] + (size_t)l * DM * DM; ld = DM; K = DM; nct = 32; dst = (bf16_t*)(ws + WS_WOUT); }
        else if ((u -= T_OUT) < T_GU) { kind = 2; src = p->in[15] + (size_t)l * DM * FF; ld = FF; K = DM; nct = 176; dst = (bf16_t*)(ws + WS_WGU); }
        else { u -= T_GU; kind = 1; src = p->in[19] + (size_t)l * FF * DM; ld = DM; K = FF; nct = 32; dst = (bf16_t*)(ws + WS_WD); }
        const int kb = u / nct, nb = u - kb * nct, k0 = kb * 64, n0 = nb * 64;
        int sc = n0;
        if (kind == 0) sc = n0 + (n0 >= 4096 ? 16 : 0);
        if (kind == 2 && n0 >= FF) { src = p->in[16] + (size_t)l * DM * FF; sc = n0 - FF; }
        {
            const int r = tid >> 4, c4 = tid & 15;
#pragma unroll
            for (int i = 0; i < 2; ++i) {
                const float4 v = *(const float4*)(src + (size_t)(k0 + r + 32 * i) * ld + sc + 4 * c4);
                LAS float* d = tile + (r + 32 * i) * 65 + 4 * c4;
                d[0] = v.x; d[1] = v.y; d[2] = v.z; d[3] = v.w;
            }
        }
        __syncthreads();
        {
            const int n = tid >> 3, kc = tid & 7;
            float v[8];
#pragma unroll
            for (int e = 0; e < 8; ++e) v[e] = tile[(kc * 8 + e) * 65 + n];
            u32x4 w; w.x = pk(v[0], v[1]); w.y = pk(v[2], v[3]); w.z = pk(v[4], v[5]); w.w = pk(v[6], v[7]);
            *(u32x4*)(dst + (size_t)(n0 + n) * K + k0 + kc * 8) = w;
        }
        __syncthreads();
    }
}

__device__ __forceinline__ void norm1_phase(KP p, int l, LAS float* wT) {
    const int tid = fresh_tid(), lane = tid & 63, wave = tid >> 6, G = gridDim.x;
    const float* x = (l == 0) ? p->in[0] : p->out;
    const float* gn = p->in[1] + (size_t)l * DM;
    const float* wsl = p->in[2] + (size_t)l * DM * INC + 4096;
    bf16_t* h = (bf16_t*)(p->ws + WS_H);
    float* beta = (float*)(p->ws + WS_BETA); float* gg = (float*)(p->ws + WS_G);
    for (int idx = tid; idx < DM * 4; idx += 512) {
        const int k = idx >> 2, j4 = idx & 3;
        const float4 v = *(const float4*)(wsl + (size_t)k * INC + 4 * j4);
        wT[(4 * j4 + 0) * DM + k] = v.x; wT[(4 * j4 + 1) * DM + k] = v.y; wT[(4 * j4 + 2) * DM + k] = v.z; wT[(4 * j4 + 3) * DM + k] = v.w;
    }
    __syncthreads();
    const float alog = (lane >= 8 && lane < 16) ? p->in[4][l * 8 + lane - 8] : 0.f;
    const float dtb = (lane >= 8 && lane < 16) ? p->in[5][l * 8 + lane - 8] : 0.f;
    for (int row = blockIdx.x * 8 + wave; row < NTOK; row += G * 8) {
        float4 xv[8]; float ss = 0.f;
#pragma unroll
        for (int i = 0; i < 8; ++i) { xv[i] = *(const float4*)(x + (size_t)row * DM + 4 * (lane + 64 * i)); ss += xv[i].x * xv[i].x + xv[i].y * xv[i].y + xv[i].z * xv[i].z + xv[i].w * xv[i].w; }
        ss = wave_sum(ss);
        const float rstd = rsqrtf(ss * (1.f / DM) + 1e-6f);
#pragma unroll
        for (int i = 0; i < 8; ++i) { const float4 gv = *(const float4*)(gn + 4 * (lane + 64 * i));
            xv[i].x *= rstd * gv.x; xv[i].y *= rstd * gv.y; xv[i].z *= rstd * gv.z; xv[i].w *= rstd * gv.w;
            u32x2 w; w.x = pk(xv[i].x, xv[i].y); w.y = pk(xv[i].z, xv[i].w);
            *(u32x2*)(h + (size_t)row * DM + 4 * (lane + 64 * i)) = w; }
        float mine = 0.f;
#pragma unroll
        for (int j = 0; j < 16; ++j) {
            float a = 0.f;
#pragma unroll
            for (int i = 0; i < 8; ++i) { const f32x4 w = *(const LAS f32x4*)(wT + j * DM + 4 * (lane + 64 * i)); a += xv[i].x * w[0] + xv[i].y * w[1] + xv[i].z * w[2] + xv[i].w * w[3]; }
            a = wave_sum(a);
            mine = (lane == j) ? a : mine;
            asm volatile("" ::: "memory");
        }
        if (lane < 8) beta[(size_t)row * 8 + lane] = sigm_f(mine);
        else if (lane < 16) { const float z = mine + dtb; const float sp = fmaxf(z, 0.f) + log1pf(__expf(-fabsf(z))); gg[(size_t)row * 8 + lane - 8] = -__expf(alog) * sp; }
    }
}
template <bool F32OUT>
__device__ __forceinline__ void norm_phase(const float* x, const float* gn, bf16_t* hb, float* of) {
    const int tid = fresh_tid(), lane = tid & 63, wave = tid >> 6, G = gridDim.x;
    for (int row = blockIdx.x * 8 + wave; row < NTOK; row += G * 8) {
        float4 xv[8]; float ss = 0.f;
#pragma unroll
        for (int i = 0; i < 8; ++i) { xv[i] = *(const float4*)(x + (size_t)row * DM + 4 * (lane + 64 * i)); ss += xv[i].x * xv[i].x + xv[i].y * xv[i].y + xv[i].z * xv[i].z + xv[i].w * xv[i].w; }
        ss = wave_sum(ss);
        const float rstd = rsqrtf(ss * (1.f / DM) + 1e-6f);
#pragma unroll
        for (int i = 0; i < 8; ++i) { const float4 gv = *(const float4*)(gn + 4 * (lane + 64 * i));
            xv[i].x *= rstd * gv.x; xv[i].y *= rstd * gv.y; xv[i].z *= rstd * gv.z; xv[i].w *= rstd * gv.w;
            if (F32OUT) *(float4*)(of + (size_t)row * DM + 4 * (lane + 64 * i)) = xv[i];
            else { u32x2 w; w.x = pk(xv[i].x, xv[i].y); w.y = pk(xv[i].z, xv[i].w); *(u32x2*)(hb + (size_t)row * DM + 4 * (lane + 64 * i)) = w; } }
    }
}

__device__ __forceinline__ void gmlp_phase(KP p, int l, LAS unsigned char* lds) {
    const int tid = fresh_tid(), lane = tid & 63, wave = tid >> 6, fr = lane & 15, fq = lane >> 4, G = gridDim.x;
    LAS bf16_t* vgT = (LAS bf16_t*)lds;
    LAS float* st = (LAS float*)(lds + 128 * 136 * 2);
    const bf16_t* Tu = (const bf16_t*)(p->ws + WS_PROJ) + 4 * SPL;
    const bf16_t* Tv = (const bf16_t*)(p->ws + WS_PROJ) + 5 * SPL;
    bf16_t* yb = (bf16_t*)(p->ws + WS_YB);
    const float* lng = p->in[7] + (size_t)l * 1024; const float* lnb = p->in[8] + (size_t)l * 1024;
    const float* sgw = p->in[9] + (size_t)l * 8 * 128 * 128; const float* sgb = p->in[10] + (size_t)l * 8 * 128;
    for (int it = blockIdx.x; it < 128; it += G) {
        const int tok0 = it * 128;
        for (int tt = 0; tt < 16; ++tt) {
            const int tk = wave * 16 + tt;
            const bf16_t* rp = Tv + (size_t)(tok0 + tk) * 1024 + lane * 16;
            const u32x4 a = *(const u32x4*)rp, b = *(const u32x4*)(rp + 8);
            const unsigned wv[8] = {a.x, a.y, a.z, a.w, b.x, b.y, b.z, b.w};
            float s = 0.f, q = 0.f;
#pragma unroll
            for (int e = 0; e < 8; ++e) { const float g0 = gelu_f(bflo(wv[e])), g1 = gelu_f(bfhi(wv[e])); s += g0 + g1; q += g0 * g0 + g1 * g1; }
            s = wave_sum(s); q = wave_sum(q);
            const float mean = s * (1.f / 1024.f), var = fmaxf(q * (1.f / 1024.f) - mean * mean, 0.f);
            if (lane == 0) { st[2 * tk] = mean; st[2 * tk + 1] = rsqrtf(var + 1e-6f); }
        }
        __syncthreads();
        for (int g = 0; g < 8; ++g) {
            {
                const int j = tid >> 2, cb = (tid & 3) * 32;
                const float mean = st[2 * j], rstd = st[2 * j + 1];
                const bf16_t* rp = Tv + (size_t)(tok0 + j) * 1024 + g * 128 + cb;
#pragma unroll
                for (int q4 = 0; q4 < 4; ++q4) {
                    const u32x4 a = *(const u32x4*)(rp + q4 * 8);
                    const unsigned wv[4] = {a.x, a.y, a.z, a.w};
#pragma unroll
                    for (int e = 0; e < 4; ++e) {
                        const int c = cb + q4 * 8 + 2 * e;
                        const float v0 = (gelu_f(bflo(wv[e])) - mean) * rstd * lng[g * 128 + c] + lnb[g * 128 + c];
                        const float v1 = (gelu_f(bfhi(wv[e])) - mean) * rstd * lng[g * 128 + c + 1] + lnb[g * 128 + c + 1];
                        const unsigned pw = pk(v0, v1);
                        vgT[c * 136 + j] = (bf16_t)(pw & 0xffffu); vgT[(c + 1) * 136 + j] = (bf16_t)(pw >> 16);
                    }
                }
            }
            __syncthreads();
            {
                const int i = wave * 16 + fr;
                const int nkk = (wave * 16 + 15) / 32 + 1;
                bf16x8 yf[4];
#pragma unroll
                for (int kk = 0; kk < 4; ++kk) {
                    float v[8];
                    const float* wp = sgw + ((size_t)g * 128 + i) * 128 + 32 * kk + 8 * fq;
                    const float4 a = *(const float4*)wp, b = *(const float4*)(wp + 4);
                    v[0] = a.x; v[1] = a.y; v[2] = a.z; v[3] = a.w; v[4] = b.x; v[5] = b.y; v[6] = b.z; v[7] = b.w;
#pragma unroll
                    for (int e = 0; e < 8; ++e) v[e] = (32 * kk + 8 * fq + e <= i) ? v[e] : 0.f;
                    yf[kk] = pack8(v);
                }
                const float bi = sgb[g * 128 + i];
#pragma unroll
                for (int mt = 0; mt < 8; ++mt) {
                    f32x4 d = {0.f, 0.f, 0.f, 0.f};
#pragma unroll
                    for (int kk = 0; kk < 4; ++kk) if (kk < nkk) {
                        const bf16x8 xf = *(const LAS bf16x8*)(vgT + (16 * mt + fr) * 136 + 32 * kk + 8 * fq);
                        d = MFMA(xf, yf[kk], d);
                    }
                    const size_t off = (size_t)(tok0 + i) * 1024 + g * 128 + 16 * mt + 4 * fq;
                    const u32x2 uv = *(const u32x2*)(Tu + off);
                    const float r0 = gelu_f(bflo(uv.x)) * (d[0] + bi), r1 = gelu_f(bfhi(uv.x)) * (d[1] + bi), r2 = gelu_f(bflo(uv.y)) * (d[2] + bi), r3 = gelu_f(bfhi(uv.y)) * (d[3] + bi);
                    u32x2 w; w.x = pk(r0, r1); w.y = pk(r2, r3);
                    *(u32x2*)(yb + off) = w;
                }
            }
            __syncthreads();
        }
    }
}

__device__ __forceinline__ void conv32(const bf16_t* xrow, int s, const float* wrow, float (&o)[4][8]) {
#pragma unroll
    for (int kk = 0; kk < 4; ++kk)
#pragma unroll
        for (int e = 0; e < 8; ++e) o[kk][e] = 0.f;
#pragma unroll 1
    for (int r = 0; r < 4; ++r) {
        if (s - r >= 0) {
#pragma unroll
            for (int kk = 0; kk < 4; ++kk) {
                const u32x2 x0 = *(const u32x2*)(xrow + 32 * kk), x1 = *(const u32x2*)(xrow + 32 * kk + 16);
                const float4 w0 = *(const float4*)(wrow + 32 * kk), w1 = *(const float4*)(wrow + 32 * kk + 16);
                o[kk][0] += w0.x * bflo(x0.x); o[kk][1] += w0.y * bfhi(x0.x); o[kk][2] += w0.z * bflo(x0.y); o[kk][3] += w0.w * bfhi(x0.y);
                o[kk][4] += w1.x * bflo(x1.x); o[kk][5] += w1.y * bfhi(x1.x); o[kk][6] += w1.z * bflo(x1.y); o[kk][7] += w1.w * bfhi(x1.y);
            }
        }
        xrow -= 1024; wrow -= 3072;
    }
#pragma unroll
    for (int kk = 0; kk < 4; ++kk)
#pragma unroll
        for (int e = 0; e < 8; ++e) o[kk][e] = silu_f(o[kk][e]);
}

__device__ __forceinline__ void dn_chunk(KP p, int l, int b, int n, int h, LAS float* Tm  , LAS float* sc  ) {
    const int lane = fresh_tid() & 63, fr = lane & 15, fq = lane >> 4;
    unsigned char* ws = p->ws;
    const bf16_t* Tq = (const bf16_t*)(ws + WS_PROJ);
    const bf16_t* Tk = Tq + SPL; const bf16_t* Tv = Tq + 2 * SPL;
    const float* cw = p->in[3] + (size_t)l * 4 * 3072;
    const int tok0 = b * SEQ + 64 * n, s0 = 64 * n, cid = (b * 8 + h) * 64 + n;
    u32x4* wf = (u32x4*)(ws + WS_WF) + (size_t)cid * 1024;
    u32x4* qdf = (u32x4*)(ws + WS_QDF) + (size_t)cid * 1024;
    u32x4* kdf = (u32x4*)(ws + WS_KDF) + (size_t)cid * 1024;
    u32x4* atf = (u32x4*)(ws + WS_ATTN) + (size_t)cid * 512;
    u32x2* uf = (u32x2*)(ws + WS_UF) + (size_t)cid * 2048;
    LAS float* sgc = sc; LAS float* sbt = sc + 64; LAS float* seg = sc + 128; LAS float* srk = sc + 192;

    float gl;
    {
        float gcs = ((const float*)(ws + WS_G))[(size_t)(tok0 + lane) * 8 + h];
        const float bj_own = ((const float*)(ws + WS_BETA))[(size_t)(tok0 + lane) * 8 + h];
#pragma unroll
        for (int o = 1; o < 64; o <<= 1) { const float t = __shfl_up(gcs, o); if (lane >= o) gcs += t; }
        gl = __shfl(gcs, 63);
        sgc[lane] = gcs; sbt[lane] = bj_own; seg[lane] = __expf(gcs);
        if (lane == 0) ((float*)(ws + WS_GL))[cid] = gl;
    }
    for (int r = 0; r < 64; ++r) Tm[r * 68 + lane] = 0.f;
    LDS_FENCE();

    u32x4* ktmp = (u32x4*)(ws + WS_O) + (size_t)cid * 1024;
#pragma unroll 1
    for (int mt = 0; mt < 4; ++mt) {
        const int j = 16 * mt + fr;
        float kv[4][8]; float ss = 0.f;
        conv32(Tk + (size_t)(tok0 + j) * 1024 + h * 128 + 4 * fq, s0 + j, cw + 3 * 3072 + 1024 + h * 128 + 4 * fq, kv);
#pragma unroll
        for (int kk = 0; kk < 4; ++kk)
#pragma unroll
            for (int e = 0; e < 8; ++e) ss += kv[kk][e] * kv[kk][e];
        ss += __shfl_xor(ss, 16); ss += __shfl_xor(ss, 32);
        const float rn = rsqrtf(ss + 1e-6f);
        if (fq == 0) srk[j] = rn;
#pragma unroll
        for (int kk = 0; kk < 4; ++kk) {
#pragma unroll
            for (int e = 0; e < 8; ++e) kv[kk][e] *= rn;
            ktmp[(mt * 4 + kk) * 64 + lane] = __builtin_bit_cast(u32x4, pack8(kv[kk]));
        }
    }
    asm volatile("s_waitcnt vmcnt(0) lgkmcnt(0)" ::: "memory");
#pragma unroll 1
    for (int mt = 0; mt < 4; ++mt) {
        const int i = 16 * mt + fr;
        bf16x8 qf[4], kfm[4];
        {
            float qv[4][8]; float ss = 0.f;
            conv32(Tq + (size_t)(tok0 + i) * 1024 + h * 128 + 4 * fq, s0 + i, cw + 3 * 3072 + h * 128 + 4 * fq, qv);
#pragma unroll
            for (int kk = 0; kk < 4; ++kk)
#pragma unroll
                for (int e = 0; e < 8; ++e) ss += qv[kk][e] * qv[kk][e];
            ss += __shfl_xor(ss, 16); ss += __shfl_xor(ss, 32);
            const float rn = rsqrtf(ss + 1e-6f) * 0.08838834764831845f;
            const float egi = seg[i];
#pragma unroll
            for (int kk = 0; kk < 4; ++kk) {
                float qd[8];
#pragma unroll
                for (int e = 0; e < 8; ++e) { qv[kk][e] *= rn; qd[e] = qv[kk][e] * egi; }
                qf[kk] = pack8(qv[kk]);
                qdf[(mt * 4 + kk) * 64 + lane] = __builtin_bit_cast(u32x4, pack8(qd));
                kfm[kk] = __builtin_bit_cast(bf16x8, ktmp[(mt * 4 + kk) * 64 + lane]);
            }
        }
        const float gci = sgc[i], bi = sbt[i];
#pragma unroll 1
        for (int k2 = 0; k2 < 2; ++k2) {
            f32x4 at[2];
#pragma unroll
            for (int hf = 0; hf < 2; ++hf) {
                const int nt = 2 * k2 + hf;
                at[hf] = (f32x4){0.f, 0.f, 0.f, 0.f};
                if (nt <= mt) {
                    f32x4 dq = {0.f, 0.f, 0.f, 0.f}, dk = {0.f, 0.f, 0.f, 0.f};
#pragma unroll
                    for (int kk = 0; kk < 4; ++kk) { const bf16x8 kfn = __builtin_bit_cast(bf16x8, ktmp[(nt * 4 + kk) * 64 + lane]); dq = MFMA(kfn, qf[kk], dq); dk = MFMA(kfn, kfm[kk], dk); }
                    const f32x4 gcj = *(const LAS f32x4*)(sgc + 16 * nt + 4 * fq);
                    f32x4 lv;
#pragma unroll
                    for (int jj = 0; jj < 4; ++jj) {
                        const int j = 16 * nt + 4 * fq + jj;
                        const float dec = (j <= i) ? __expf(gci - gcj[jj]) : 0.f;
                        at[hf][jj] = dq[jj] * dec;
                        lv[jj] = (j < i) ? bi * dk[jj] * dec : 0.f;
                    }
                    *(LAS f32x4*)(Tm + i * 68 + 16 * nt + 4 * fq) = lv;
                }
            }
            atf[(mt * 2 + k2) * 64 + lane] = __builtin_bit_cast(u32x4, pack44(at[0], at[1]));
            asm volatile("" ::: "memory");
        }
    }
    asm volatile("s_waitcnt vmcnt(0) lgkmcnt(0)" ::: "memory");
#pragma unroll 1
    for (int i = 0; i < 64; ++i) {
        float acc = (lane == i) ? 1.f : 0.f;
#pragma unroll 1
        for (int j = 0; j < i; j += 4) {
            const f32x4 lv = *(const LAS f32x4*)(Tm + i * 68 + j);
            acc -= lv[0] * Tm[(j + 0) * 68 + lane];
            if (j + 1 < i) acc -= lv[1] * Tm[(j + 1) * 68 + lane];
            if (j + 2 < i) acc -= lv[2] * Tm[(j + 2) * 68 + lane];
            if (j + 3 < i) acc -= lv[3] * Tm[(j + 3) * 68 + lane];
        }
        LDS_FENCE();
        Tm[i * 68 + lane] = (lane <= i) ? acc : 0.f;
        LDS_FENCE();
    }
    bf16x8 Tf[4][2];
#pragma unroll
    for (int mt = 0; mt < 4; ++mt)
#pragma unroll
        for (int k2 = 0; k2 < 2; ++k2) {
            const f32x4 a = *(const LAS f32x4*)(Tm + (16 * mt + fr) * 68 + 32 * k2 + 4 * fq), bb = *(const LAS f32x4*)(Tm + (16 * mt + fr) * 68 + 32 * k2 + 16 + 4 * fq);
            Tf[mt][k2] = pack44(a, bb);
        }
#pragma unroll 1
    for (int ct = 0; ct < 8; ++ct) {
        const int c = 16 * ct + fr;
        float cwk[4], cwv[4];
#pragma unroll
        for (int r = 0; r < 4; ++r) { cwk[r] = cw[(3 - r) * 3072 + 1024 + h * 128 + c]; cwv[r] = cw[(3 - r) * 3072 + 2048 + h * 128 + c]; }
        bf16x8 kbf[2], vbf[2];
#pragma unroll
        for (int k2 = 0; k2 < 2; ++k2) {
            float kb[8], kd[8], vb[8];
#pragma unroll
            for (int run = 0; run < 2; ++run) {
                const int jb = 32 * k2 + 16 * run + 4 * fq;
                const bf16_t* pk_ = Tk + (ptrdiff_t)(tok0 + jb - 3) * 1024 + h * 128 + c;
                const bf16_t* pv_ = Tv + (ptrdiff_t)(tok0 + jb - 3) * 1024 + h * 128 + c;
                float xk[7], xv[7];
#pragma unroll
                for (int d = 0; d < 7; ++d) {
                    const bool ok = (s0 + jb - 3 + d >= 0);
                    xk[d] = ok ? bf2f(pk_[d * 1024]) : 0.f; xv[d] = ok ? bf2f(pv_[d * 1024]) : 0.f;
                }
                const f32x4 rk4 = *(const LAS f32x4*)(srk + jb), bt4 = *(const LAS f32x4*)(sbt + jb), eg4 = *(const LAS f32x4*)(seg + jb), gc4 = *(const LAS f32x4*)(sgc + jb);
#pragma unroll
                for (int e = 0; e < 4; ++e) {
                    float ak = 0.f, av = 0.f;
#pragma unroll
                    for (int r = 0; r < 4; ++r) { ak += cwk[r] * xk[3 + e - r]; av += cwv[r] * xv[3 + e - r]; }
                    const float kn = silu_f(ak) * rk4[e], vv = silu_f(av);
                    kb[4 * run + e] = kn * bt4[e] * eg4[e];
                    kd[4 * run + e] = kn * __expf(gl - gc4[e]);
                    vb[4 * run + e] = vv * bt4[e];
                }
                asm volatile("" ::: "memory");
            }
            kbf[k2] = pack8(kb); vbf[k2] = pack8(vb);
            kdf[(ct * 2 + k2) * 64 + lane] = __builtin_bit_cast(u32x4, pack8(kd));
        }
#pragma unroll
        for (int mt = 0; mt < 4; ++mt) {
            f32x4 d = {0.f, 0.f, 0.f, 0.f};
            d = MFMA(Tf[mt][0], vbf[0], d); d = MFMA(Tf[mt][1], vbf[1], d);
            u32x2 w; w.x = pk(d[0], d[1]); w.y = pk(d[2], d[3]);
            uf[(ct * 4 + mt) * 64 + lane] = w;
            f32x4 e2 = {0.f, 0.f, 0.f, 0.f};
            e2 = MFMA(kbf[0], Tf[mt][0], e2); e2 = MFMA(kbf[1], Tf[mt][1], e2);
            u32x2 w2; w2.x = pk(-e2[0], -e2[1]); w2.y = pk(-e2[2], -e2[3]);
            ((u32x2*)wf)[((mt * 4 + (ct >> 1)) * 64 + lane) * 2 + (ct & 1)] = w2;
        }
    }
}

__device__ __forceinline__ void dn_chunk_phase(KP p, int l, LAS unsigned char* lds) {
    const int wave = fresh_tid() >> 6, G = gridDim.x;
    LAS float* Tm = (LAS float*)(lds + wave * 18432);
    LAS float* sc = (LAS float*)(lds + wave * 18432 + 17408);
    for (int it = blockIdx.x; it < 256; it += G) dn_chunk(p, l, it >> 6, it & 63, wave, Tm, sc);
}

__device__ __forceinline__ void dn_scan_phase(KP p) {
    const int lane = fresh_tid() & 63, wave = fresh_tid() >> 6, fr = lane & 15, fq = lane >> 4, G = gridDim.x;
    unsigned char* ws = p->ws;
    bf16_t* ob = (bf16_t*)(ws + WS_O);
    for (int c = blockIdx.x + G * wave; c < 256; c += G * 8) {
        const int xcd = c & 7, idx = c >> 3, sl = idx & 7, bh = xcd * 4 + (idx >> 3), b = bh >> 3, h = bh & 7;
        f32x4 S[8]; bf16x8 Sf[4];
#pragma unroll
        for (int m = 0; m < 8; ++m) S[m] = (f32x4){0.f, 0.f, 0.f, 0.f};
#pragma unroll
        for (int k = 0; k < 4; ++k) Sf[k] = (bf16x8){0, 0, 0, 0, 0, 0, 0, 0};
#pragma unroll 1
        for (int n = 0; n < 64; ++n) {
            const int cid = bh * 64 + n;
            const bf16x8* wf = (const bf16x8*)(ws + WS_WF) + (size_t)cid * 1024 + lane;
            const bf16x8* qdf = (const bf16x8*)(ws + WS_QDF) + (size_t)cid * 1024 + lane;
            const bf16x8* kdf = (const bf16x8*)(ws + WS_KDF) + (size_t)cid * 1024 + lane;
            const bf16x8* atf = (const bf16x8*)(ws + WS_ATTN) + (size_t)cid * 512 + lane;
            const u32x2* uf = (const u32x2*)(ws + WS_UF) + (size_t)cid * 2048 + (size_t)sl * 256 + lane;
            const float egl = __expf(((const float*)(ws + WS_GL))[cid]);
            f32x4 vn[4];
#pragma unroll
            for (int mt = 0; mt < 4; ++mt) {
                const u32x2 uu = uf[mt * 64];
                f32x4 a = {bflo(uu.x), bfhi(uu.x), bflo(uu.y), bfhi(uu.y)};
#pragma unroll
                for (int kk = 0; kk < 4; ++kk) a = MFMA(wf[(mt * 4 + kk) * 64], Sf[kk], a);
                vn[mt] = a;
            }
            bf16x8 Vf[2];
            Vf[0] = pack44(vn[0], vn[1]); Vf[1] = pack44(vn[2], vn[3]);
            const int tokb = b * SEQ + 64 * n;
#pragma unroll
            for (int mt = 0; mt < 4; ++mt) {
                f32x4 a = {0.f, 0.f, 0.f, 0.f};
#pragma unroll
                for (int kk = 0; kk < 4; ++kk) a = MFMA(qdf[(mt * 4 + kk) * 64], Sf[kk], a);
                a = MFMA(atf[(mt * 2 + 0) * 64], Vf[0], a); a = MFMA(atf[(mt * 2 + 1) * 64], Vf[1], a);
#pragma unroll
                for (int jj = 0; jj < 4; ++jj) ob[(size_t)(tokb + 16 * mt + 4 * fq + jj) * 1024 + h * 128 + sl * 16 + fr] = (bf16_t)(pk(a[jj], 0.f) & 0xffffu);
            }
#pragma unroll
            for (int mt = 0; mt < 8; ++mt) {
                f32x4 a = S[mt] * egl;
                a = MFMA(kdf[(mt * 2 + 0) * 64], Vf[0], a); a = MFMA(kdf[(mt * 2 + 1) * 64], Vf[1], a);
                S[mt] = a;
            }
#pragma unroll
            for (int kk = 0; kk < 4; ++kk) Sf[kk] = pack44(S[2 * kk], S[2 * kk + 1]);
        }
    }
}

__device__ __forceinline__ void ya_phase(KP p, int l) {
    const int lane = fresh_tid() & 63, wave = fresh_tid() >> 6, G = gridDim.x;
    const bf16_t* ob = (const bf16_t*)(p->ws + WS_O);
    const bf16_t* Tz = (const bf16_t*)(p->ws + WS_PROJ) + 3 * SPL;
    bf16_t* ya = (bf16_t*)(p->ws + WS_YA);
    const float* og = p->in[6] + (size_t)l * 128 + (lane & 7) * 16;
    for (int row = blockIdx.x * 8 + wave; row < NTOK; row += G * 8) {
        const size_t off = (size_t)row * 1024 + lane * 16;
        const u32x4 a = *(const u32x4*)(ob + off), b = *(const u32x4*)(ob + off + 8);
        const u32x4 za = *(const u32x4*)(Tz + off), zb = *(const u32x4*)(Tz + off + 8);
        const unsigned ov[8] = {a.x, a.y, a.z, a.w, b.x, b.y, b.z, b.w}, zv[8] = {za.x, za.y, za.z, za.w, zb.x, zb.y, zb.z, zb.w};
        float o[16]; float ss = 0.f;
#pragma unroll
        for (int e = 0; e < 8; ++e) { o[2 * e] = bflo(ov[e]); o[2 * e + 1] = bfhi(ov[e]); ss += o[2 * e] * o[2 * e] + o[2 * e + 1] * o[2 * e + 1]; }
        ss += __shfl_xor(ss, 1); ss += __shfl_xor(ss, 2); ss += __shfl_xor(ss, 4);
        const float rstd = rsqrtf(ss * (1.f / 128.f) + 1e-6f);
        unsigned w[8];
#pragma unroll
        for (int e = 0; e < 8; ++e) {
            const float r0 = o[2 * e] * rstd * og[2 * e] * silu_f(bflo(zv[e])), r1 = o[2 * e + 1] * rstd * og[2 * e + 1] * silu_f(bfhi(zv[e]));
            w[e] = pk(r0, r1);
        }
        *(u32x4*)(ya + off) = (u32x4){w[0], w[1], w[2], w[3]}; *(u32x4*)(ya + off + 8) = (u32x4){w[4], w[5], w[6], w[7]};
    }
}

__device__ __forceinline__ void ffn_act_phase(KP p, int l) {
    const bf16_t* gu = (const bf16_t*)(p->ws + WS_GU);
    bf16_t* hid = (bf16_t*)(p->ws + WS_HID);
    const float* cw = p->in[17] + (size_t)l * 3 * FF; const float* cb = p->in[18] + (size_t)l * FF;
    const int nitem = (NTOK / 8) * (FF / 8);
    for (int it = blockIdx.x * 512 + fresh_tid(); it < nitem; it += gridDim.x * 512) {
        const int cb8 = it % (FF / 8), tb = it / (FF / 8), c0 = cb8 * 8, t0 = tb * 8;
        float w0[8], w1[8], w2[8], bb[8];
#pragma unroll
        for (int e = 0; e < 8; ++e) { w0[e] = cw[c0 + e]; w1[e] = cw[FF + c0 + e]; w2[e] = cw[2 * FF + c0 + e]; bb[e] = cb[c0 + e]; }
        float g2[8], g1[8];
        const bool first = (t0 % SEQ) == 0;
        {
            u32x4 a = {0u, 0u, 0u, 0u}, b = {0u, 0u, 0u, 0u};
            if (!first) { a = *(const u32x4*)(gu + (size_t)(t0 - 2) * (2 * FF) + c0); b = *(const u32x4*)(gu + (size_t)(t0 - 1) * (2 * FF) + c0); }
            const unsigned av[4] = {a.x, a.y, a.z, a.w}, bv[4] = {b.x, b.y, b.z, b.w};
#pragma unroll
            for (int e = 0; e < 4; ++e) { g2[2 * e] = bflo(av[e]); g2[2 * e + 1] = bfhi(av[e]); g1[2 * e] = bflo(bv[e]); g1[2 * e + 1] = bfhi(bv[e]); }
        }
#pragma unroll
        for (int tt = 0; tt < 8; ++tt) {
            const u32x4 a = *(const u32x4*)(gu + (size_t)(t0 + tt) * (2 * FF) + c0), u = *(const u32x4*)(gu + (size_t)(t0 + tt) * (2 * FF) + FF + c0);
            const unsigned av[4] = {a.x, a.y, a.z, a.w}, uv[4] = {u.x, u.y, u.z, u.w};
            float g0[8], r[8];
#pragma unroll
            for (int e = 0; e < 4; ++e) { g0[2 * e] = bflo(av[e]); g0[2 * e + 1] = bfhi(av[e]); }
#pragma unroll
            for (int e = 0; e < 8; ++e) {
                const float gt = w0[e] * g2[e] + w1[e] * g1[e] + w2[e] * g0[e] + bb[e];
                const float up = (e & 1) ? bfhi(uv[e >> 1]) : bflo(uv[e >> 1]);
                r[e] = silu_f(gt) * up;
                g2[e] = g1[e]; g1[e] = g0[e];
            }
            *(u32x4*)(hid + (size_t)(t0 + tt) * FF + c0) = (u32x4){pk(r[0], r[1]), pk(r[2], r[3]), pk(r[4], r[5]), pk(r[6], r[7])};
        }
    }
}

constexpr int PH_PER_LAYER = 11, PH_TOTAL = 2 * PH_PER_LAYER + 1;
__global__ void __launch_bounds__(512, 2) mega(Params pa) {
    extern __shared__ __attribute__((aligned(16))) unsigned char lds_raw[];
    LAS unsigned char* lds = (LAS unsigned char*)lds_raw;
    cg::grid_group grid = cg::this_grid();
    const int ph_lo = pa.ph_lo, ph_hi = pa.ph_hi;
#define GSYNC() do { asm volatile("s_waitcnt vmcnt(0) lgkmcnt(0)" ::: "memory"); __builtin_amdgcn_fence(__ATOMIC_RELEASE, "agent"); asm volatile("s_waitcnt vmcnt(0)" ::: "memory"); grid.sync(); __builtin_amdgcn_fence(__ATOMIC_ACQUIRE, "agent"); asm volatile("s_waitcnt vmcnt(0)" ::: "memory"); } while (0)
#define RUN(k) (ph_lo <= (k) && (k) < ph_hi)
#define SEAM(k) do { if (RUN(k) && RUN((k) + 1)) { GSYNC(); } } while (0)
#pragma unroll 1
    for (int l0 = 0; l0 < NL; ++l0) {
        const int pb = l0 * PH_PER_LAYER;
        if (RUN(pb + 0)) { KP p = get_kp(); const int l = launder_i(l0); xpose_phase(p, l, (LAS float*)lds); __syncthreads(); }
        if (RUN(pb + 0)) { KP p = get_kp(); const int l = launder_i(l0); norm1_phase(p, l, (LAS float*)lds); }
        SEAM(pb + 0);
        if (RUN(pb + 1)) { KP p = get_kp(); unsigned char* ws = p->ws; const int G = gridDim.x, bid = blockIdx.x;
            pg8::Gemm g{(const bf16_t*)(ws + WS_H), (const bf16_t*)(ws + WS_WIN), NTOK, NIN, DM}; pg8::StaticOrder S; S.init(NTOK, NIN, G, bid);
            pg8::EpiBf16<0> E{(bf16_t*)(ws + WS_PROJ), 1024, nullptr, 1024, SPL};
            pg8::gemm_phase<pg8::EpiBf16<0>, pg8::StaticOrder, false>(lds, g, S, E, nullptr);
        }
        SEAM(pb + 1);
        if (RUN(pb + 2)) { KP p = get_kp(); const int l = launder_i(l0); gmlp_phase(p, l, lds); __syncthreads(); }
        if (RUN(pb + 2)) { KP p = get_kp(); const int l = launder_i(l0); dn_chunk_phase(p, l, lds); }
        SEAM(pb + 2);
        if (RUN(pb + 3)) { KP p = get_kp(); dn_scan_phase(p); }
        SEAM(pb + 3);
        if (RUN(pb + 4)) { KP p = get_kp(); const int l = launder_i(l0); ya_phase(p, l); }
        SEAM(pb + 4);
        if (RUN(pb + 5)) { KP p = get_kp(); unsigned char* ws = p->ws; const int G = gridDim.x, bid = blockIdx.x;
            pg8::Gemm g{(const bf16_t*)(ws + WS_YA), (const bf16_t*)(ws + WS_WA), NTOK, DM, 1024}; pg8::StaticOrder S; S.init(NTOK, DM, G, bid);
            EpiGateA E{(float*)(ws + WS_TMP), (const bf16_t*)(ws + WS_PROJ) + 6 * SPL};
            pg8::gemm_phase<EpiGateA, pg8::StaticOrder, false>(lds, g, S, E, nullptr); }
        if (RUN(pb + 5)) { KP p = get_kp(); unsigned char* ws = p->ws; const int G = gridDim.x, bid = blockIdx.x;
            pg8::Gemm g{(const bf16_t*)(ws + WS_YB), (const bf16_t*)(ws + WS_WB), NTOK, DM, 1024}; pg8::StaticOrder S; S.init(NTOK, DM, G, bid);
            EpiGateB E{(const float*)(ws + WS_TMP), (const bf16_t*)(ws + WS_PROJ) + 8 * SPL, (bf16_t*)(ws + WS_MRG)};
            pg8::gemm_phase<EpiGateB, pg8::StaticOrder, false>(lds, g, S, E, nullptr); }
        SEAM(pb + 5);
        if (RUN(pb + 6)) { KP p = get_kp(); unsigned char* ws = p->ws; const int G = gridDim.x, bid = blockIdx.x; const int l = launder_i(l0);
            pg8::Gemm g{(const bf16_t*)(ws + WS_MRG), (const bf16_t*)(ws + WS_WOUT), NTOK, DM, DM}; pg8::StaticOrder S; S.init(NTOK, DM, G, bid);
            EpiRes E{(l == 0) ? p->in[0] : (const float*)p->out, p->out};
            pg8::gemm_phase<EpiRes, pg8::StaticOrder, false>(lds, g, S, E, nullptr);
        }
        SEAM(pb + 6);
        if (RUN(pb + 7)) { KP p = get_kp(); const int l = launder_i(l0); norm_phase<false>(p->out, p->in[14] + (size_t)l * DM, (bf16_t*)(p->ws + WS_H2), nullptr); }
        SEAM(pb + 7);
        if (RUN(pb + 8)) { KP p = get_kp(); unsigned char* ws = p->ws; const int G = gridDim.x, bid = blockIdx.x;
            pg8::Gemm g{(const bf16_t*)(ws + WS_H2), (const bf16_t*)(ws + WS_WGU), NTOK, 2 * FF, DM}; pg8::StaticOrder S; S.init(NTOK, 2 * FF, G, bid);
            pg8::EpiBf16<0> E{(bf16_t*)(ws + WS_GU), 2 * FF, nullptr, 0, 0};
            pg8::gemm_phase<pg8::EpiBf16<0>, pg8::StaticOrder, false>(lds, g, S, E, nullptr);
        }
        SEAM(pb + 8);
        if (RUN(pb + 9)) { KP p = get_kp(); const int l = launder_i(l0); ffn_act_phase(p, l); }
        SEAM(pb + 9);
        if (RUN(pb + 10)) { KP p = get_kp(); unsigned char* ws = p->ws; const int G = gridDim.x, bid = blockIdx.x;
            pg8::Gemm g{(const bf16_t*)(ws + WS_HID), (const bf16_t*)(ws + WS_WD), NTOK, DM, FF}; pg8::StaticOrder S; S.init(NTOK, DM, G, bid);
            EpiRes E{(const float*)p->out, p->out};
            pg8::gemm_phase<EpiRes, pg8::StaticOrder, false>(lds, g, S, E, nullptr);
        }
        SEAM(pb + 10);
    }
    if (pa.dbg) { KP p = get_kp(); unsigned char* ws = p->ws; float* out = p->out;
        GSYNC();
        const size_t NH = (size_t)NTOK * 1024;
        for (size_t i = (size_t)blockIdx.x * 512 + fresh_tid(); i < NH; i += (size_t)gridDim.x * 512) {
            float a = 0.f, b = 0.f;
            if (pa.dbg == 1) { a = bf2f(((const bf16_t*)(ws + WS_WF))[i]) + bf2f(((const bf16_t*)(ws + WS_KDF))[i]); b = bf2f(((const bf16_t*)(ws + WS_QDF))[i]) + bf2f(((const bf16_t*)(ws + WS_UF))[i]); }
            if (pa.dbg == 2) { a = (i < NH / 2) ? bf2f(((const bf16_t*)(ws + WS_ATTN))[i]) : ((i - NH / 2 < 2048) ? ((const float*)(ws + WS_GL))[i - NH / 2] : 0.f); b = (i < 262144) ? ((const float*)(ws + WS_BETA))[i] + ((const float*)(ws + WS_G))[i] : 0.f; }
            if (pa.dbg == 3) { a = bf2f(((const bf16_t*)(ws + WS_O))[i]); b = bf2f(((const bf16_t*)(ws + WS_YB))[i]); }
            if (!(fabsf(a) < 1e30f)) a = 12345.f; if (!(fabsf(b) < 1e30f)) b = 12345.f;
            out[i] = a; out[NH + i] = b;
        }
        return; }
    if (RUN(PH_TOTAL - 1)) { KP p = get_kp(); norm_phase<true>(p->out, p->in[20], nullptr, p->out); }
#undef RUN
#undef SEAM
}
}

#ifndef DBG_MODE
#define DBG_MODE 0
#define DBG_HI mk::PH_TOTAL
#endif
extern "C" void kernel_launch(void* const* d_in, const int* in_sizes, int n_in, void* d_out, int out_size, void* d_ws, size_t ws_size, hipStream_t stream) {
    static int grid = 0;
    if (grid == 0) {
        if (n_in != 21 || ws_size < mk::WS_END) { fprintf(stderr, "kernel_launch: need 21 inputs and >= %zu bytes of workspace; got %d, %zu\n", (size_t)mk::WS_END, n_in, ws_size); grid = -1; return; }
        int dev = 0, cus = 0, per_cu = 0;
        hipGetDevice(&dev);
        hipDeviceGetAttribute(&cus, hipDeviceAttributeMultiprocessorCount, dev);
        if (hipFuncSetAttribute((const void*)mk::mega, hipFuncAttributeMaxDynamicSharedMemorySize, mk::LDS_BYTES) != hipSuccess) { fprintf(stderr, "kernel_launch: hipFuncSetAttribute failed\n"); grid = -1; return; }
        if (hipOccupancyMaxActiveBlocksPerMultiprocessor(&per_cu, (const void*)mk::mega, 512, mk::LDS_BYTES) != hipSuccess || per_cu < 1) { fprintf(stderr, "kernel_launch: occupancy query says %d\n", per_cu); per_cu = 1; }
        (void)hipGetLastError();
        grid = cus * 1;
    }
    if (grid < 0) return;
    mk::Params p{};
    for (int i = 0; i < 21; ++i) p.in[i] = (const float*)d_in[i];
    p.out = (float*)d_out; p.ws = (unsigned char*)d_ws; p.ph_lo = 0; p.ph_hi = DBG_HI; p.dbg = DBG_MODE;
    void* args[] = {&p};
    hipError_t e = hipLaunchCooperativeKernel((const void*)mk::mega, dim3(grid), dim3(512), args, mk::LDS_BYTES, stream);
    if (e != hipSuccess) fprintf(stderr, "cooperative launch failed: %s (grid %d)\n", hipGetErrorString(e), grid);
}
```

```cpp
#include <hip/hip_runtime.h>
#include <hip/hip_cooperative_groups.h>
#include <cstdio>
namespace cg = cooperative_groups;
__device__ __forceinline__ int fresh_tid() { int t = threadIdx.x; asm volatile("" : "+v"(t)); return t; }
namespace pg8 {
#define PG8_LAS __attribute__((address_space(3)))
typedef unsigned short bf16_t;
typedef short bf16x8 __attribute__((ext_vector_type(8)));
typedef float f32x4 __attribute__((ext_vector_type(4)));
typedef unsigned u32x4 __attribute__((ext_vector_type(4)));
constexpr int BM = 256, BK = 64, HALF = 128, HTB = HALF * BK * 2  , STAGE_BYTES = 8 * HTB, NXCD = 8, WGM = 8;

__host__ __device__ __forceinline__ int lds_byte(int r, int c) { const int st = (r >> 4) * 2 + (c >> 5), rr = r & 15, cc = c & 31, ob = rr * 64 + cc * 2; return st * 1024 + (ob ^ (((ob >> 9) & 1) << 5)); }
__host__ __device__ __forceinline__ void stage_rc(int b, int& R, int& C) { const int st = b / 1024, sb = b % 1024, swz = sb ^ (((sb >> 9) & 1) << 5); R = (st >> 1) * 16 + swz / 64; C = (st & 1) * 32 + (swz % 64) / 2; }
__host__ __device__ __forceinline__ int perm32(int rho) { const int n = rho >> 4, i = rho & 15; return 8 * (i >> 2) + 4 * n + (i & 3); }

struct Unit { int pm, pn, kh; };
struct Gemm { const bf16_t* A; const bf16_t* Bt; int M, N, K, ld; };

struct StaticOrder {
    int nM, nN, nwg, G, c;
    __host__ __device__ void init(int M, int N, int G_, int c_) { nM = M / BM; nN = N / BM; nwg = nM * nN; G = G_; c = c_; }
    __host__ __device__ __forceinline__ bool next(int i, Unit& u) const {
        const long L = (long)i * G + c; if (L >= nwg) return false;
        int wgid = (int)L; { const int q = nwg / NXCD, r = nwg % NXCD, xcd = wgid % NXCD, off = wgid / NXCD; wgid = (xcd < r ? xcd * (q + 1) : r * (q + 1) + (xcd - r) * q) + off; }
        const int nig = WGM * nN, gid = wgid / nig, fm = gid * WGM, gsz = (nM - fm) < WGM ? (nM - fm) : WGM;
        u.pm = fm + ((wgid % nig) % gsz); u.pn = (wgid % nig) / gsz; u.kh = 0; return true;
    }
    __device__ __forceinline__ void a_ready(const Unit&) const {}
    __device__ __forceinline__ void done(const Unit&) const {}
};
__device__ __forceinline__ unsigned cvt_pk_bf16(float lo, float hi) { unsigned r; asm volatile("v_cvt_pk_bf16_f32 %0, %1, %2" : "=v"(r) : "v"(lo), "v"(hi)); return r; }
typedef float f32x2 __attribute__((ext_vector_type(2)));
__device__ __forceinline__ f32x2 gelu_pk(f32x2 v) {
    const f32x2 av = __builtin_elementwise_abs(v), d = av * 0.2316418882f + 1.0f;
    f32x2 t; t.x = __builtin_amdgcn_rcpf(d.x); t.y = __builtin_amdgcn_rcpf(d.y);
    f32x2 q = t * 0.5307027145f + (-0.7265760135f); q = q * t + 0.7107068705f; q = q * t + (-0.142248368f); q = q * t + 0.127414796f; q = q * t;
    const f32x2 s = (v * v) * (-0.72134752044f);
    f32x2 e; e.x = __builtin_amdgcn_exp2f(s.x); e.y = __builtin_amdgcn_exp2f(s.y);
    const f32x2 m = v * (q * e), r = v - m;
    f32x2 o; o.x = v.x < 0.f ? m.x : r.x; o.y = v.y < 0.f ? m.y : r.y; return o;
}

struct EpiF32 {
    static constexpr bool PERM = false, AFTER_DRAIN = false, SPLITK = false;
    float* C; int ldc; const float* bias;
    __device__ __forceinline__ void operator()(const f32x4 (&acc)[2][2][4][2], const Unit& u, int wr, int wc, int fr, int fq) const {
        const int row0 = u.pm * BM + wr * 64 + fr, col0 = u.pn * BM + wc * 32 + 4 * fq;
        f32x4 bv[2][2];
#pragma unroll
        for (int bj = 0; bj < 2; ++bj)
#pragma unroll
            for (int n = 0; n < 2; ++n) bv[bj][n] = bias ? *(const f32x4*)(bias + col0 + bj * HALF + n * 16) : (f32x4){0.f, 0.f, 0.f, 0.f};
#pragma unroll
        for (int ai = 0; ai < 2; ++ai)
#pragma unroll
            for (int m = 0; m < 4; ++m) { float* rowp = C + (size_t)(row0 + ai * HALF + m * 16) * ldc + col0;
#pragma unroll
                for (int bj = 0; bj < 2; ++bj)
#pragma unroll
                    for (int n = 0; n < 2; ++n) *(f32x4*)(rowp + bj * HALF + n * 16) = acc[ai][bj][m][n] + bv[bj][n]; }
    }
};
template <int ACT  > struct EpiBf16 {
    static constexpr bool PERM = true, AFTER_DRAIN = false, SPLITK = false;
    bf16_t* O; int ldc; const float* bias; int split_cols; size_t split_stride;
    __device__ __forceinline__ void operator()(const f32x4 (&acc)[2][2][4][2], const Unit& u, int wr, int wc, int fr, int fq) const {
        const int row0 = u.pm * BM + wr * 64 + fr; int colt = u.pn * BM; bf16_t* base = O;
        if (split_cols) { const int t = colt / split_cols; base += (size_t)t * split_stride; colt -= t * split_cols; }
        const int col0 = colt + wc * 32 + 8 * fq, bcol0 = u.pn * BM + wc * 32 + 8 * fq;
        f32x4 bv[2][2];
#pragma unroll
        for (int bj = 0; bj < 2; ++bj)
#pragma unroll
            for (int n = 0; n < 2; ++n) bv[bj][n] = bias ? *(const f32x4*)(bias + bcol0 + bj * HALF + 4 * n) : (f32x4){0.f, 0.f, 0.f, 0.f};
#pragma unroll
        for (int ai = 0; ai < 2; ++ai)
#pragma unroll
            for (int m = 0; m < 4; ++m) { bf16_t* rowp = base + (size_t)(row0 + ai * HALF + m * 16) * ldc + col0;
#pragma unroll
                for (int bj = 0; bj < 2; ++bj) { f32x4 v0 = acc[ai][bj][m][0] + bv[bj][0], v1 = acc[ai][bj][m][1] + bv[bj][1];
                    if (ACT == 1) { f32x2 a = gelu_pk((f32x2){v0[0], v0[1]}), b = gelu_pk((f32x2){v0[2], v0[3]}), c = gelu_pk((f32x2){v1[0], v1[1]}), d = gelu_pk((f32x2){v1[2], v1[3]});
                        v0 = (f32x4){a.x, a.y, b.x, b.y}; v1 = (f32x4){c.x, c.y, d.x, d.y}; }
                    if (ACT == 2) {
#pragma unroll
                        for (int j = 0; j < 4; ++j) { v0[j] = 0.5f * v0[j] * (1.0f + erff(v0[j] * 0.70710678f)); v1[j] = 0.5f * v1[j] * (1.0f + erff(v1[j] * 0.70710678f)); } }
                    u32x4 w; w.x = cvt_pk_bf16(v0[0], v0[1]); w.y = cvt_pk_bf16(v0[2], v0[3]); w.z = cvt_pk_bf16(v1[0], v1[1]); w.w = cvt_pk_bf16(v1[2], v1[3]);
                    *(u32x4*)(rowp + bj * HALF) = w; } }
    }
};
template <class Epi, class Sched, bool STAMP = false, bool ALIGN_EPI = false, bool SP2 = false>
__device__ __forceinline__ void gemm_phase(PG8_LAS unsigned char* lds, const Gemm g, const Sched& S, const Epi& E, unsigned long long* stamps) {
    const int tid = fresh_tid(), wid = __builtin_amdgcn_readfirstlane(tid >> 6), lane = tid & 63, wr = wid >> 2, wc = wid & 3, fr = lane & 15, fq = lane >> 4;
    const int K = g.K, nt = K / BK, LD = g.ld ? g.ld : g.K;
    int ts_lo = 0, ts_hi = 0, nts = 0; const unsigned long long rt_entry = STAMP ? (unsigned long long)wall_clock64() : 0ull;
#define PG8_STAMP() do { if (STAMP && wid == 0 && nts < 64) { const unsigned long long _c = (unsigned long long)clock64(); \
        ts_lo = (lane == nts) ? (int)(unsigned)_c : ts_lo; ts_hi = (lane == nts) ? (int)(unsigned)(_c >> 32) : ts_hi; ++nts; } } while (0)
    PG8_STAMP();
    unsigned voffA[2], voffB[2];
#pragma unroll
    for (int i = 0; i < 2; ++i) { int R, C; stage_rc(tid * 16 + i * 8192, R, C); const int Rb = Epi::PERM ? ((R & ~31) + perm32(R & 31)) : R;
        voffA[i] = (unsigned)(R * LD + C) * 2u; voffB[i] = (unsigned)(Rb * LD + C) * 2u; }
    const size_t kstep = (size_t)(BK * 2);
    const size_t hstep = (size_t)HALF * LD * 2;
    const size_t tstep = 2 * hstep;
    const unsigned ldsw = (unsigned)wid * 1024u;
    const int aoff = lds_byte(wr * 64 + fr, fq * 8), boff = lds_byte(wc * 32 + fr, fq * 8);
#define PG8_SA(b, h) (((b) * 2 + (h)) * HTB)
#define PG8_SB(b, h) ((4 + (b) * 2 + (h)) * HTB)
#define PG8_STAGE(bufoff, gbase, voff) do { _Pragma("unroll") for (int _i = 0; _i < 2; ++_i) \
        __builtin_amdgcn_global_load_lds((const unsigned*)((const char*)(gbase) + (voff)[_i]), (PG8_LAS unsigned*)(lds + (bufoff) + ldsw + _i * 8192), 16, 0, 0); } while (0)
#define PG8_LDA(dst, b, h) do { _Pragma("unroll") for (int m = 0; m < 4; ++m) _Pragma("unroll") for (int k = 0; k < 2; ++k) dst[m][k] = *(const PG8_LAS bf16x8*)(lds + PG8_SA(b, h) + aoff + m * 2048 + k * 1024); } while (0)
#define PG8_LDB(dst, b, h) do { _Pragma("unroll") for (int n = 0; n < 2; ++n) _Pragma("unroll") for (int k = 0; k < 2; ++k) dst[n][k] = *(const PG8_LAS bf16x8*)(lds + PG8_SB(b, h) + boff + n * 2048 + k * 1024); } while (0)
#define PG8_MMA(ai, bj, At, Bt) do { __builtin_amdgcn_s_setprio(1); _Pragma("unroll") for (int m = 0; m < 4; ++m) _Pragma("unroll") for (int n = 0; n < 2; ++n) _Pragma("unroll") for (int k = 0; k < 2; ++k) \
        acc[ai][bj][m][n] = __builtin_amdgcn_mfma_f32_16x16x32_bf16(Bt[n][k], At[m][k], acc[ai][bj][m][n], 0, 0, 0); __builtin_amdgcn_s_setprio(0); } while (0)
#define PG8_WAIT_V(n) asm volatile("s_waitcnt vmcnt(" #n ")" ::: "memory")
#define PG8_WAIT_L(n) asm volatile("s_waitcnt lgkmcnt(" #n ")" ::: "memory")
#define PG8_BAR __builtin_amdgcn_s_barrier()
#define PG8_SCHED __builtin_amdgcn_sched_barrier(0)
    Unit cur, nxt; int ui = 0;
    if (!S.next(0, cur)) return;
    f32x4 acc[2][2][4][2];
#pragma unroll
    for (int a = 0; a < 2; ++a)
#pragma unroll
        for (int b = 0; b < 2; ++b)
#pragma unroll
            for (int m = 0; m < 4; ++m)
#pragma unroll
                for (int n = 0; n < 2; ++n) acc[a][b][m][n] = (f32x4){0.f, 0.f, 0.f, 0.f};
    bf16x8 At[4][2], B0[2][2], B1[2][2];
    const char* cA = (const char*)g.A + (size_t)cur.pm * tstep + (size_t)cur.kh * K * 2; const char* cB = (const char*)g.Bt + (size_t)cur.pn * tstep + (size_t)cur.kh * K * 2;
    S.a_ready(cur);
    if constexpr (SP2) {
        PG8_STAGE(PG8_SB(0, 0), cB, voffB); PG8_STAGE(PG8_SB(0, 1), cB + hstep, voffB); PG8_STAGE(PG8_SA(0, 0), cA, voffA); PG8_STAGE(PG8_SA(0, 1), cA + hstep, voffA);
        if (wr == 1) PG8_BAR;
        PG8_WAIT_V(2); PG8_BAR;
        PG8_STAGE(PG8_SB(1, 0), cB + kstep, voffB); PG8_STAGE(PG8_SA(1, 0), cA + kstep, voffA); PG8_STAGE(PG8_SB(1, 1), cB + hstep + kstep, voffB);
        PG8_WAIT_V(6); PG8_BAR;
    } else {
    PG8_STAGE(PG8_SB(0, 0), cB, voffB); PG8_STAGE(PG8_SA(0, 0), cA, voffA); PG8_STAGE(PG8_SB(0, 1), cB + hstep, voffB); PG8_STAGE(PG8_SA(0, 1), cA + hstep, voffA);
    if (wr == 1) PG8_BAR;
    PG8_WAIT_V(4); PG8_BAR;
    PG8_STAGE(PG8_SB(1, 0), cB + kstep, voffB); PG8_STAGE(PG8_SA(1, 0), cA + kstep, voffA); PG8_STAGE(PG8_SB(1, 1), cB + hstep + kstep, voffB);
    PG8_WAIT_V(6); PG8_BAR;
    }
    PG8_STAMP();
    for (;;) {
        const bool has_next = S.next(ui + 1, nxt);
        const char* nA = has_next ? (const char*)g.A + (size_t)nxt.pm * tstep + (size_t)nxt.kh * K * 2 : cA; const char* nB = has_next ? (const char*)g.Bt + (size_t)nxt.pn * tstep + (size_t)nxt.kh * K * 2 : cB;
        for (int t = 0; t < nt; t += 2) {
            const bool last = (t == nt - 2);
            const char* a1 = cA + (size_t)(t + 1) * kstep;
            const char* a2 = last ? nA : cA + (size_t)(t + 2) * kstep; const char* b2 = last ? nB : cB + (size_t)(t + 2) * kstep;
            const char* a3 = a2 + kstep; const char* b3 = b2 + kstep;
            if (last && has_next) S.a_ready(nxt);
            if constexpr (SP2) {
            PG8_LDB(B0, 0, 0); PG8_LDB(B1, 0, 1); PG8_SCHED; PG8_LDA(At, 0, 0); PG8_STAGE(PG8_SA(1, 1), a1 + hstep, voffA);
            PG8_WAIT_V(8); PG8_WAIT_L(0); PG8_BAR; PG8_MMA(0, 0, At, B0); PG8_MMA(0, 1, At, B1); PG8_BAR; PG8_SCHED;
            PG8_LDA(At, 0, 1); PG8_STAGE(PG8_SB(0, 0), b2, voffB); PG8_STAGE(PG8_SB(0, 1), b2 + hstep, voffB); PG8_STAGE(PG8_SA(0, 0), a2, voffA);
            PG8_WAIT_V(8); PG8_WAIT_L(0); PG8_BAR; PG8_MMA(1, 0, At, B0); PG8_MMA(1, 1, At, B1); PG8_BAR; PG8_SCHED;
            PG8_LDB(B0, 1, 0); PG8_LDB(B1, 1, 1); PG8_SCHED; PG8_LDA(At, 1, 0); PG8_STAGE(PG8_SA(0, 1), a2 + hstep, voffA);
            PG8_WAIT_V(8); PG8_WAIT_L(0); PG8_BAR; PG8_MMA(0, 0, At, B0); PG8_MMA(0, 1, At, B1); PG8_BAR; PG8_SCHED;
            PG8_LDA(At, 1, 1); PG8_STAGE(PG8_SB(1, 0), b3, voffB); PG8_STAGE(PG8_SB(1, 1), b3 + hstep, voffB); PG8_STAGE(PG8_SA(1, 0), a3, voffA);
            PG8_WAIT_V(8); PG8_WAIT_L(0); PG8_BAR; PG8_MMA(1, 0, At, B0); PG8_MMA(1, 1, At, B1); PG8_BAR; PG8_SCHED;
            } else {
            PG8_LDB(B0, 0, 0); PG8_SCHED; PG8_LDA(At, 0, 0); PG8_STAGE(PG8_SA(1, 1), a1 + hstep, voffA);
            PG8_WAIT_L(8); PG8_BAR; PG8_WAIT_L(0); PG8_MMA(0, 0, At, B0); PG8_BAR; PG8_SCHED;
            PG8_LDB(B1, 0, 1); PG8_STAGE(PG8_SB(0, 0), b2, voffB);
            PG8_BAR; PG8_WAIT_L(0); PG8_MMA(0, 1, At, B1); PG8_BAR;
            PG8_LDA(At, 0, 1); PG8_STAGE(PG8_SA(0, 0), a2, voffA);
            PG8_BAR; PG8_WAIT_L(0); PG8_MMA(1, 0, At, B0); PG8_BAR; PG8_SCHED;
            PG8_STAGE(PG8_SB(0, 1), b2 + hstep, voffB);
            PG8_WAIT_V(6); PG8_BAR; PG8_MMA(1, 1, At, B1); PG8_BAR;
            PG8_LDB(B0, 1, 0); PG8_SCHED; PG8_LDA(At, 1, 0); PG8_STAGE(PG8_SA(0, 1), a2 + hstep, voffA);
            PG8_WAIT_L(8); PG8_BAR; PG8_WAIT_L(0); PG8_MMA(0, 0, At, B0); PG8_BAR; PG8_SCHED;
            PG8_LDB(B1, 1, 1); PG8_STAGE(PG8_SB(1, 0), b3, voffB);
            PG8_BAR; PG8_WAIT_L(0); PG8_MMA(0, 1, At, B1); PG8_BAR;
            PG8_LDA(At, 1, 1); PG8_STAGE(PG8_SA(1, 0), a3, voffA);
            PG8_BAR; PG8_WAIT_L(0); PG8_MMA(1, 0, At, B0); PG8_BAR; PG8_SCHED;
            PG8_STAGE(PG8_SB(1, 1), b3 + hstep, voffB);
            PG8_WAIT_V(6); PG8_BAR; PG8_MMA(1, 1, At, B1); PG8_BAR;
            }
        }
        PG8_STAMP();
        if constexpr (ALIGN_EPI) { if (wr == 0) PG8_BAR; }
        if constexpr (Epi::SPLITK) { if (cur.kh == 0) E.mid(acc, cur, wr, wc, fr, fq); else E(acc, cur, wr, wc, fr, fq); }
        else if constexpr (!Epi::AFTER_DRAIN) { E(acc, cur, wr, wc, fr, fq); S.done(cur); }
        PG8_STAMP();
        if (!has_next) break;
        if (!(Epi::SPLITK && cur.kh == 0))
#pragma unroll
        for (int a = 0; a < 2; ++a)
#pragma unroll
            for (int b = 0; b < 2; ++b)
#pragma unroll
                for (int m = 0; m < 4; ++m)
#pragma unroll
                    for (int n = 0; n < 2; ++n) acc[a][b][m][n] = (f32x4){0.f, 0.f, 0.f, 0.f};
        cur = nxt; cA = nA; cB = nB; ++ui;
        if constexpr (ALIGN_EPI) { if (wr == 1) PG8_BAR; }
    }
    PG8_WAIT_V(0);
    if constexpr (!ALIGN_EPI) { if (wr == 0) PG8_BAR; }
    PG8_BAR;
    if constexpr (Epi::AFTER_DRAIN) { E.fused(acc, cur, wr, wc, fr, fq, lds, wid, lane); S.done(cur); }
    PG8_STAMP();
    if (STAMP && wid == 0) { stamps[lane] = lane < nts ? (((unsigned long long)(unsigned)ts_hi << 32) | (unsigned)ts_lo) : 0ull;
        if (lane == 62) stamps[62] = rt_entry; if (lane == 63) stamps[63] = (unsigned long long)wall_clock64(); }
#undef PG8_STAMP
#undef PG8_SA
#undef PG8_SB
#undef PG8_STAGE
#undef PG8_LDA
#undef PG8_LDB
#undef PG8_MMA
#undef PG8_WAIT_V
#undef PG8_WAIT_L
#undef PG8_BAR
#undef PG8_SCHED
}
}

#ifndef DBLC
#define DBLC 0
#endif
#ifndef GEMM_SP2
#define GEMM_SP2 true
#endif
#ifndef GEMM_ALIGN
#define GEMM_ALIGN true
#endif
namespace mk {
#define LAS __attribute__((address_space(3)))
using pg8::bf16_t; using pg8::bf16x8; using pg8::f32x4; using pg8::u32x4;
typedef unsigned u32x2 __attribute__((ext_vector_type(2)));

constexpr int NTOK = 16384, DM = 2048, SEQ = 4096, NIN = 10240, INC = 10256, FF = 5632, NL = 2;
constexpr size_t MiB = (size_t)1 << 20;
constexpr size_t SPL = (size_t)NTOK * 1024;
constexpr size_t WS_WA = 0, WS_WB = 4 * MiB, WS_WOUT = 8 * MiB, WS_WGU = 16 * MiB, WS_WD = 60 * MiB;
constexpr size_t WS_WIN = 82 * MiB;
constexpr size_t WS_ATTN = 82 * MiB, WS_GL = 98 * MiB;
constexpr size_t WS_H = 122 * MiB;
constexpr size_t WS_Y = 122 * MiB;
constexpr size_t WS_O = 186 * MiB;
constexpr size_t WS_PROJ = 186 * MiB;
constexpr size_t WS_MRG = 218 * MiB;
constexpr size_t WS_BETA = 506 * MiB, WS_G = 506 * MiB + 512 * 1024;
constexpr size_t WS_WF = 507 * MiB, WS_QDF = 539 * MiB, WS_KDF = 571 * MiB, WS_UF = 603 * MiB;
constexpr size_t WS_TMP = 507 * MiB;
constexpr size_t WS_H2 = 577 * MiB;
constexpr size_t WS_GU = 82 * MiB;
constexpr size_t WS_HID = 100 * MiB;
constexpr size_t WS_HALO = 507 * MiB, WS_FIXG = 519 * MiB, WS_FIXU = 531 * MiB;
constexpr size_t WS_END = 641 * MiB;
constexpr int LDS_BYTES = 160 * 1024;

struct Params { const float* in[21]; float* out; unsigned char* ws; int ph_lo, ph_hi, dbg, pad; };
typedef const Params __attribute__((address_space(4)))* KP;
__device__ __forceinline__ KP get_kp() { KP k = (KP)__builtin_amdgcn_kernarg_segment_ptr(); asm volatile("" : "+s"(k)); return k; }
__device__ __forceinline__ int launder_i(int v) { asm volatile("" : "+s"(v)); return v; }

__device__ __forceinline__ float bflo(unsigned u) { return __uint_as_float(u << 16); }
__device__ __forceinline__ float bfhi(unsigned u) { return __uint_as_float(u & 0xffff0000u); }
__device__ __forceinline__ float bf2f(bf16_t b) { return __uint_as_float(((unsigned)b) << 16); }
typedef __bf16 bf2_t __attribute__((ext_vector_type(2)));
typedef float f2_t __attribute__((ext_vector_type(2)));
__device__ __forceinline__ unsigned pk(float lo, float hi) { f2_t v = {lo, hi}; bf2_t r = __builtin_convertvector(v, bf2_t); return __builtin_bit_cast(unsigned, r); }
__device__ __forceinline__ float silu_f(float x) { return x * __builtin_amdgcn_rcpf(1.f + __expf(-x)); }
__device__ __forceinline__ float sigm_f(float x) { return __builtin_amdgcn_rcpf(1.f + __expf(-x)); }
__device__ __forceinline__ void gelu2(float a, float b, float& ra, float& rb) { const pg8::f32x2 r = pg8::gelu_pk((pg8::f32x2){a, b}); ra = r.x; rb = r.y; }
__device__ __forceinline__ float wave_sum(float v) {
#pragma unroll
    for (int o = 32; o >= 1; o >>= 1) v += __shfl_xor(v, o);
    return v;
}
__device__ __forceinline__ bf16x8 pack8(const float (&v)[8]) {
    u32x4 w; w.x = pk(v[0], v[1]); w.y = pk(v[2], v[3]); w.z = pk(v[4], v[5]); w.w = pk(v[6], v[7]);
    return __builtin_bit_cast(bf16x8, w);
}
__device__ __forceinline__ bf16x8 pack44(f32x4 a, f32x4 b) {
    u32x4 w; w.x = pk(a[0], a[1]); w.y = pk(a[2], a[3]); w.z = pk(b[0], b[1]); w.w = pk(b[2], b[3]);
    return __builtin_bit_cast(bf16x8, w);
}
#define MFMA(a, b, c) __builtin_amdgcn_mfma_f32_16x16x32_bf16((a), (b), (c), 0, 0, 0)
#define LDS_FENCE() asm volatile("s_waitcnt lgkmcnt(0)" ::: "memory")
#define LDS_BARRIER() do { asm volatile("s_waitcnt lgkmcnt(0)" ::: "memory"); __builtin_amdgcn_s_barrier(); asm volatile("" ::: "memory"); } while (0)

struct EpiRes {
    static constexpr bool PERM = false, AFTER_DRAIN = false, SPLITK = false;
    const float* base; float* out;
    __device__ __forceinline__ void operator()(const f32x4 (&acc)[2][2][4][2], const pg8::Unit& u, int wr, int wc, int fr, int fq) const {
        const int row0 = u.pm * 256 + wr * 64 + fr, col0 = u.pn * 256 + wc * 32 + 4 * fq;
#pragma unroll
        for (int ai = 0; ai < 2; ++ai)
#pragma unroll
            for (int m = 0; m < 4; ++m) { const size_t off = (size_t)(row0 + ai * 128 + m * 16) * DM + col0;
#pragma unroll
                for (int bj = 0; bj < 2; ++bj)
#pragma unroll
                    for (int n = 0; n < 2; ++n) { const f32x4 b = *(const f32x4*)(base + off + bj * 128 + n * 16); *(f32x4*)(out + off + bj * 128 + n * 16) = b + acc[ai][bj][m][n]; }
                asm volatile("" ::: "memory"); }
    }
};
struct EpiMerge {
    static constexpr bool PERM = false, AFTER_DRAIN = false, SPLITK = true;
    const bf16_t* ga; const bf16_t* gb; bf16_t* mrg;
    __device__ __forceinline__ void mid(f32x4 (&acc)[2][2][4][2], const pg8::Unit& u, int wr, int wc, int fr, int fq) const {
        const int row0 = u.pm * 256 + wr * 64 + fr, col0 = u.pn * 256 + wc * 32 + 4 * fq;
        const size_t gofs = (size_t)(col0 >> 10) * SPL + (col0 & 1023);
#pragma unroll
        for (int ai = 0; ai < 2; ++ai)
#pragma unroll
            for (int m = 0; m < 4; ++m) {
                u32x2 va[2][2], vb[2][2];
#pragma unroll
                for (int bj = 0; bj < 2; ++bj)
#pragma unroll
                    for (int n = 0; n < 2; ++n) { const size_t o = gofs + (size_t)(row0 + ai * 128 + m * 16) * 1024 + bj * 128 + n * 16; va[bj][n] = *(const u32x2*)(ga + o); vb[bj][n] = *(const u32x2*)(gb + o); }
#pragma unroll
                for (int bj = 0; bj < 2; ++bj)
#pragma unroll
                    for (int n = 0; n < 2; ++n) {
                        const u32x2 a = va[bj][n], bb = vb[bj][n];
                        f32x4 r;
                        r[0] = (1.f + __expf(-bflo(bb.x))) * __builtin_amdgcn_rcpf(1.f + __expf(-bflo(a.x)));
                        r[1] = (1.f + __expf(-bfhi(bb.x))) * __builtin_amdgcn_rcpf(1.f + __expf(-bfhi(a.x)));
                        r[2] = (1.f + __expf(-bflo(bb.y))) * __builtin_amdgcn_rcpf(1.f + __expf(-bflo(a.y)));
                        r[3] = (1.f + __expf(-bfhi(bb.y))) * __builtin_amdgcn_rcpf(1.f + __expf(-bfhi(a.y)));
                        acc[ai][bj][m][n] *= r;
                    }
                asm volatile("" ::: "memory");
            }
    }
    __device__ __forceinline__ void operator()(const f32x4 (&acc)[2][2][4][2], const pg8::Unit& u, int wr, int wc, int fr, int fq) const {
        const int row0 = u.pm * 256 + wr * 64 + fr, col0 = u.pn * 256 + wc * 32 + 4 * fq;
        const bf16_t* gp = gb + (size_t)(col0 >> 10) * SPL + (col0 & 1023);
#pragma unroll
        for (int ai = 0; ai < 2; ++ai)
#pragma unroll
            for (int m = 0; m < 4; ++m) { const int row = row0 + ai * 128 + m * 16;
#pragma unroll
                for (int bj = 0; bj < 2; ++bj)
#pragma unroll
                    for (int n = 0; n < 2; ++n) { const u32x2 gv = *(const u32x2*)(gp + (size_t)row * 1024 + bj * 128 + n * 16);
                        f32x4 sg; sg[0] = sigm_f(bflo(gv.x)); sg[1] = sigm_f(bfhi(gv.x)); sg[2] = sigm_f(bflo(gv.y)); sg[3] = sigm_f(bfhi(gv.y));
                        const f32x4 r = sg * acc[ai][bj][m][n];
                        u32x2 w; w.x = pk(r[0], r[1]); w.y = pk(r[2], r[3]);
                        *(u32x2*)(mrg + (size_t)row * DM + col0 + bj * 128 + n * 16) = w; }
                asm volatile("" ::: "memory"); }
    }
};
struct PairOrder { pg8::StaticOrder S;
    __device__ __forceinline__ bool next(int i, pg8::Unit& u) const { if (!S.next(i >> 1, u)) return false; u.kh = i & 1; return true; }
    __device__ __forceinline__ void a_ready(const pg8::Unit&) const {}
    __device__ __forceinline__ void done(const pg8::Unit&) const {}
};
struct OneUnit { pg8::Unit u;
    __device__ __forceinline__ bool next(int i, pg8::Unit& o) const { if (i != 0) return false; o = u; return true; }
    __device__ __forceinline__ void a_ready(const pg8::Unit&) const {}
    __device__ __forceinline__ void done(const pg8::Unit&) const {}
};
__device__ __forceinline__ float dpp_ror1(float v) { return __builtin_bit_cast(float, __builtin_amdgcn_update_dpp(0, __builtin_bit_cast(int, v), 0x121, 0xF, 0xF, false)); }
__device__ __forceinline__ float dpp_ror2(float v) { return __builtin_bit_cast(float, __builtin_amdgcn_update_dpp(0, __builtin_bit_cast(int, v), 0x122, 0xF, 0xF, false)); }
struct EpiFfn {
    static constexpr bool PERM = false, AFTER_DRAIN = false, SPLITK = false;
    bf16_t* hid; const float* cw; const float* cb; float* halo; float* fixg; float* fixu;
    __device__ __forceinline__ void operator()(const f32x4 (&acc)[2][2][4][2], const pg8::Unit& u, int wr, int wc, int fr, int fq) const {
        const int ch0 = u.pn * 128 + wc * 32 + 4 * fq;
#pragma unroll
        for (int n = 0; n < 2; ++n) {
            const f32x4 w0 = *(const f32x4*)(cw + ch0 + 16 * n), w1 = *(const f32x4*)(cw + FF + ch0 + 16 * n), w2 = *(const f32x4*)(cw + 2 * FF + ch0 + 16 * n), bb = *(const f32x4*)(cb + ch0 + 16 * n);
#pragma unroll
            for (int ai = 0; ai < 2; ++ai) {
                const int grp = u.pm * 4 + ai * 2 + wr;
#pragma unroll
                for (int m = 0; m < 4; ++m) {
                    const f32x4 g0 = acc[ai][0][m][n], up = acc[ai][1][m][n];
                    f32x4 g1, g2;
#pragma unroll
                    for (int c = 0; c < 4; ++c) {
                        const float t1 = dpp_ror1(g0[c]), t2 = dpp_ror2(g0[c]);
                        if (m > 0) { const float p1 = dpp_ror1(acc[ai][0][m > 0 ? m - 1 : 0][n][c]), p2 = dpp_ror2(acc[ai][0][m > 0 ? m - 1 : 0][n][c]); g1[c] = (fr == 0) ? p1 : t1; g2[c] = (fr < 2) ? p2 : t2; }
                        else { g1[c] = t1; g2[c] = t2; }
                    }
                    const int row = grp * 64 + m * 16 + fr;
                    if (m > 0 || fr >= 2) {
                        const f32x4 gt = w0 * g2 + w1 * g1 + w2 * g0 + bb;
                        u32x2 w; w.x = pk(silu_f(gt[0]) * up[0], silu_f(gt[1]) * up[1]); w.y = pk(silu_f(gt[2]) * up[2], silu_f(gt[3]) * up[3]);
                        *(u32x2*)(hid + (size_t)row * FF + ch0 + 16 * n) = w;
                    } else {
                        *(f32x4*)(fixg + (size_t)(grp * 2 + fr) * FF + ch0 + 16 * n) = g0;
                        *(f32x4*)(fixu + (size_t)(grp * 2 + fr) * FF + ch0 + 16 * n) = up;
                    }
                    if (m == 3 && fr >= 14) *(f32x4*)(halo + (size_t)(grp * 2 + fr - 14) * FF + ch0 + 16 * n) = g0;
                }
                asm volatile("" ::: "memory");
            }
        }
    }
};
__device__ __forceinline__ void ffn_fix_phase(KP p, int l) {
    const float* halo = (const float*)(p->ws + WS_HALO); const float* fixg = (const float*)(p->ws + WS_FIXG); const float* fixu = (const float*)(p->ws + WS_FIXU);
    bf16_t* hid = (bf16_t*)(p->ws + WS_HID);
    const float* cw = p->in[17] + (size_t)l * 3 * FF; const float* cb = p->in[18] + (size_t)l * FF;
    const int nitem = 256 * 2 * (FF / 4);
    for (int it = blockIdx.x * 512 + fresh_tid(); it < nitem; it += gridDim.x * 512) {
        const int c4 = it % (FF / 4), pr = it / (FF / 4), row = pr & 1, grp = pr >> 1, ch = 4 * c4;
        const bool hist = (grp & 63) != 0;
        const f32x4 z = {0.f, 0.f, 0.f, 0.f};
        const f32x4 g0 = *(const f32x4*)(fixg + (size_t)(grp * 2 + row) * FF + ch), up = *(const f32x4*)(fixu + (size_t)(grp * 2 + row) * FF + ch);
        f32x4 g1, g2;
        if (row == 0) { g1 = hist ? *(const f32x4*)(halo + (size_t)((grp - 1) * 2 + 1) * FF + ch) : z; g2 = hist ? *(const f32x4*)(halo + (size_t)((grp - 1) * 2 + 0) * FF + ch) : z; }
        else { g1 = *(const f32x4*)(fixg + (size_t)(grp * 2 + 0) * FF + ch); g2 = hist ? *(const f32x4*)(halo + (size_t)((grp - 1) * 2 + 1) * FF + ch) : z; }
        const f32x4 w0 = *(const f32x4*)(cw + ch), w1 = *(const f32x4*)(cw + FF + ch), w2 = *(const f32x4*)(cw + 2 * FF + ch), bb = *(const f32x4*)(cb + ch);
        const f32x4 gt = w0 * g2 + w1 * g1 + w2 * g0 + bb;
        u32x2 w; w.x = pk(silu_f(gt[0]) * up[0], silu_f(gt[1]) * up[1]); w.y = pk(silu_f(gt[2]) * up[2], silu_f(gt[3]) * up[3]);
        *(u32x2*)(hid + (size_t)(grp * 64 + row) * FF + ch) = w;
    }
}

__device__ __forceinline__ void xpose_phase(KP p, int l, LAS float* tile) {
    const int tid = fresh_tid(), G = gridDim.x;
    unsigned char* ws = p->ws;
    constexpr int T_IN = 32 * 40, T_A = 16 * 8, T_OUT = 32 * 8, T_GU = 32 * 44, T_D = 88 * 8, T_ALL = T_IN + 2 * T_A + T_OUT + T_GU + T_D;
    for (int t = blockIdx.x; t < T_ALL; t += G) {
        int u = t; const float* src; int ld, K, nct; bf16_t* dst; int kind; int ldk = 0;
        if (u < T_IN) { kind = 0; src = p->in[2] + (size_t)l * DM * INC; ld = INC; K = DM; nct = 40; dst = (bf16_t*)(ws + WS_WIN); }
        else if ((u -= T_IN) < T_A) { kind = 1; src = p->in[11] + (size_t)l * 1024 * DM; ld = DM; K = 1024; nct = 8; dst = (bf16_t*)(ws + WS_WA); ldk = 2048; }
        else if ((u -= T_A) < T_A) { kind = 1; src = p->in[12] + (size_t)l * 1024 * DM; ld = DM; K = 1024; nct = 8; dst = (bf16_t*)(ws + WS_WA) + 1024; ldk = 2048; }
        else if ((u -= T_A) < T_OUT) { kind = 1; src = p->in[13] + (size_t)l * DM * DM; ld = DM; K = DM; nct = 8; dst = (bf16_t*)(ws + WS_WOUT); }
        else if ((u -= T_OUT) < T_GU) { kind = 2; src = p->in[15] + (size_t)l * DM * FF; ld = FF; K = DM; nct = 44; dst = (bf16_t*)(ws + WS_WGU); }
        else { u -= T_GU; kind = 1; src = p->in[19] + (size_t)l * FF * DM; ld = DM; K = FF; nct = 8; dst = (bf16_t*)(ws + WS_WD); }
        const int kb = u / nct, nb = u - kb * nct, k0 = kb * 64, n0 = nb * 256;
        int sc = n0;
        if (kind == 0) sc = n0 + (n0 >= 4096 ? 16 : 0);
        {
            const int r = tid >> 6, c4 = tid & 63;
            f32x4 v[8];
            const float* srcp = src + sc + 4 * c4;
            if (kind == 2) srcp = (c4 < 32) ? src + 128 * nb + 4 * c4 : p->in[16] + (size_t)l * DM * FF + 128 * nb + 4 * (c4 - 32);
#pragma unroll
            for (int i = 0; i < 8; ++i) v[i] = __builtin_nontemporal_load((const f32x4*)(srcp + (size_t)(k0 + r + 8 * i) * ld));
#pragma unroll
            for (int i = 0; i < 8; ++i) *(LAS f32x4*)(tile + (r + 8 * i) * 260 + 4 * c4) = v[i];
        }
        __syncthreads();
#pragma unroll
        for (int j = 0; j < 4; ++j) {
            const int q = tid + 512 * j, n = q >> 3, kc = q & 7;
            float v[8];
#pragma unroll
            for (int e = 0; e < 8; ++e) v[e] = tile[(kc * 8 + e) * 260 + n];
            u32x4 w; w.x = pk(v[0], v[1]); w.y = pk(v[2], v[3]); w.z = pk(v[4], v[5]); w.w = pk(v[6], v[7]);
            *(u32x4*)(dst + (size_t)(n0 + n) * (ldk ? ldk : K) + k0 + kc * 8) = w;
        }
        __syncthreads();
    }
}

__device__ __forceinline__ void norm1_phase(KP p, int l, LAS float* wT) {
    const int tid = fresh_tid(), lane = tid & 63, wave = tid >> 6, G = gridDim.x;
    const float* x = (l == 0) ? p->in[0] : p->out;
    const float* gn = p->in[1] + (size_t)l * DM;
    const float* wsl = p->in[2] + (size_t)l * DM * INC + 4096;
    bf16_t* h = (bf16_t*)(p->ws + WS_H);
    float* beta = (float*)(p->ws + WS_BETA); float* gg = (float*)(p->ws + WS_G);
    for (int idx = tid; idx < DM * 4; idx += 512) {
        const int k = idx >> 2, j4 = idx & 3;
        const float4 v = *(const float4*)(wsl + (size_t)k * INC + 4 * j4);
        wT[(4 * j4 + 0) * DM + k] = v.x; wT[(4 * j4 + 1) * DM + k] = v.y; wT[(4 * j4 + 2) * DM + k] = v.z; wT[(4 * j4 + 3) * DM + k] = v.w;
    }
    __syncthreads();
    const float alog = (((lane >> 2) & 15) >= 8) ? p->in[4][l * 8 + ((lane >> 2) & 15) - 8] : 0.f;
    const float dtb = (((lane >> 2) & 15) >= 8) ? p->in[5][l * 8 + ((lane >> 2) & 15) - 8] : 0.f;
    for (int row = blockIdx.x * 8 + wave; row < NTOK; row += G * 8) {
        float4 xv[8]; float ss = 0.f;
#pragma unroll
        for (int i = 0; i < 8; ++i) { xv[i] = *(const float4*)(x + (size_t)row * DM + 4 * (lane + 64 * i)); ss += xv[i].x * xv[i].x + xv[i].y * xv[i].y + xv[i].z * xv[i].z + xv[i].w * xv[i].w; }
        ss = wave_sum(ss);
        const float rstd = rsqrtf(ss * (1.f / DM) + 1e-6f);
#pragma unroll
        for (int i = 0; i < 8; ++i) { const float4 gv = *(const float4*)(gn + 4 * (lane + 64 * i));
            xv[i].x *= rstd * gv.x; xv[i].y *= rstd * gv.y; xv[i].z *= rstd * gv.z; xv[i].w *= rstd * gv.w;
            u32x2 w; w.x = pk(xv[i].x, xv[i].y); w.y = pk(xv[i].z, xv[i].w);
            *(u32x2*)(h + (size_t)row * DM + 4 * (lane + 64 * i)) = w; }
        float a16[16];
#pragma unroll
        for (int j = 0; j < 16; ++j) {
            float a = 0.f;
#pragma unroll
            for (int i = 0; i < 8; ++i) { const f32x4 w = *(const LAS f32x4*)(wT + j * DM + 4 * (lane + 64 * i)); a += xv[i].x * w[0] + xv[i].y * w[1] + xv[i].z * w[2] + xv[i].w * w[3]; }
            a16[j] = a;
            if ((j & 3) == 3) asm volatile("" ::: "memory");
        }
        float b8[8], c4[4], d2[2];
        { const bool up = (lane & 32) != 0;
#pragma unroll
          for (int i = 0; i < 8; ++i) { const float snd = up ? a16[i] : a16[i + 8], keep = up ? a16[i + 8] : a16[i]; b8[i] = keep + __shfl_xor(snd, 32); } }
        { const bool up = (lane & 16) != 0;
#pragma unroll
          for (int i = 0; i < 4; ++i) { const float snd = up ? b8[i] : b8[i + 4], keep = up ? b8[i + 4] : b8[i]; c4[i] = keep + __shfl_xor(snd, 16); } }
        { const bool up = (lane & 8) != 0;
#pragma unroll
          for (int i = 0; i < 2; ++i) { const float snd = up ? c4[i] : c4[i + 2], keep = up ? c4[i + 2] : c4[i]; d2[i] = keep + __shfl_xor(snd, 8); } }
        float mine;
        { const bool up = (lane & 4) != 0; const float snd = up ? d2[0] : d2[1], keep = up ? d2[1] : d2[0]; mine = keep + __shfl_xor(snd, 4); }
        mine += __shfl_xor(mine, 2); mine += __shfl_xor(mine, 1);
        const int jj = (lane >> 2) & 15;
        if ((lane & 3) == 0) {
            if (jj < 8) beta[(size_t)row * 8 + jj] = sigm_f(mine);
            else { const float z = mine + dtb; const float sp = fmaxf(z, 0.f) + log1pf(__expf(-fabsf(z))); gg[(size_t)row * 8 + jj - 8] = -__expf(alog) * sp; }
        }
    }
}
template <bool F32OUT>
__device__ __forceinline__ void norm_phase(const float* x, const float* gn, bf16_t* hb, float* of) {
    const int tid = fresh_tid(), lane = tid & 63, wave = tid >> 6, G = gridDim.x;
    for (int row = blockIdx.x * 8 + wave; row < NTOK; row += G * 8) {
        float4 xv[8]; float ss = 0.f;
#pragma unroll
        for (int i = 0; i < 8; ++i) { xv[i] = *(const float4*)(x + (size_t)row * DM + 4 * (lane + 64 * i)); ss += xv[i].x * xv[i].x + xv[i].y * xv[i].y + xv[i].z * xv[i].z + xv[i].w * xv[i].w; }
        ss = wave_sum(ss);
        const float rstd = rsqrtf(ss * (1.f / DM) + 1e-6f);
#pragma unroll
        for (int i = 0; i < 8; ++i) { const float4 gv = *(const float4*)(gn + 4 * (lane + 64 * i));
            xv[i].x *= rstd * gv.x; xv[i].y *= rstd * gv.y; xv[i].z *= rstd * gv.z; xv[i].w *= rstd * gv.w;
            if (F32OUT) *(float4*)(of + (size_t)row * DM + 4 * (lane + 64 * i)) = xv[i];
            else { u32x2 w; w.x = pk(xv[i].x, xv[i].y); w.y = pk(xv[i].z, xv[i].w); *(u32x2*)(hb + (size_t)row * DM + 4 * (lane + 64 * i)) = w; } }
    }
}

__device__ __forceinline__ void gmlp_phase(KP p, int l, LAS unsigned char* lds) {
    const int tid = fresh_tid(), lane = tid & 63, wave = tid >> 6, fr = lane & 15, fq = lane >> 4, G = gridDim.x;
    LAS bf16_t* vgT = (LAS bf16_t*)lds;
    LAS float* st = (LAS float*)(lds + 128 * 136 * 2);
    const bf16_t* Tu = (const bf16_t*)(p->ws + WS_PROJ) + 4 * SPL;
    const bf16_t* Tv = (const bf16_t*)(p->ws + WS_PROJ) + 5 * SPL;
    bf16_t* yb = (bf16_t*)(p->ws + WS_Y) + 1024;
    const float* lng = p->in[7] + (size_t)l * 1024; const float* lnb = p->in[8] + (size_t)l * 1024;
    const float* sgw = p->in[9] + (size_t)l * 8 * 128 * 128; const float* sgb = p->in[10] + (size_t)l * 8 * 128;
    for (int it = blockIdx.x; it < 256; it += G) {
        const int tok0 = (it >> 1) * 128, g0 = (it & 1) * 4;
        for (int t4 = 0; t4 < 4; ++t4) {
            u32x4 ra[4], rb[4];
#pragma unroll
            for (int q = 0; q < 4; ++q) { const bf16_t* rp = Tv + (size_t)(tok0 + wave * 16 + t4 * 4 + q) * 1024 + lane * 16; ra[q] = *(const u32x4*)rp; rb[q] = *(const u32x4*)(rp + 8); }
            float sv[4], qv[4];
#pragma unroll
            for (int q = 0; q < 4; ++q) {
                const unsigned wv[8] = {ra[q].x, ra[q].y, ra[q].z, ra[q].w, rb[q].x, rb[q].y, rb[q].z, rb[q].w};
                float s = 0.f, qq = 0.f;
#pragma unroll
                for (int e = 0; e < 8; ++e) { float g0_, g1_; gelu2(bflo(wv[e]), bfhi(wv[e]), g0_, g1_); s += g0_ + g1_; qq += g0_ * g0_ + g1_ * g1_; }
                sv[q] = s; qv[q] = qq;
            }
#pragma unroll
            for (int o = 32; o >= 1; o >>= 1) {
#pragma unroll
                for (int q = 0; q < 4; ++q) { sv[q] += __shfl_xor(sv[q], o); qv[q] += __shfl_xor(qv[q], o); }
            }
            if (lane < 4) {
                const float s = (lane == 0) ? sv[0] : (lane == 1) ? sv[1] : (lane == 2) ? sv[2] : sv[3];
                const float qq = (lane == 0) ? qv[0] : (lane == 1) ? qv[1] : (lane == 2) ? qv[2] : qv[3];
                const float mean = s * (1.f / 1024.f), var = fmaxf(qq * (1.f / 1024.f) - mean * mean, 0.f);
                const int tk = wave * 16 + t4 * 4 + lane;
                st[2 * tk] = mean; st[2 * tk + 1] = rsqrtf(var + 1e-6f);
            }
        }
        const int bj = tid >> 2, bcb = (tid & 3) * 32;
        const int mi = wave * 16 + fr;
        const int nkk = (wave * 16 + 15) / 32 + 1;
        u32x4 tvr[4]; f32x4 lg[8], lb[8]; f32x4 swr[8]; u32x2 uvr[8]; float bi;
#define GM_LOAD_A(g) do { const bf16_t* rp = Tv + (size_t)(tok0 + bj) * 1024 + (g) * 128 + bcb; \
            _Pragma("unroll") for (int q4 = 0; q4 < 4; ++q4) tvr[q4] = *(const u32x4*)(rp + q4 * 8); \
            _Pragma("unroll") for (int q8 = 0; q8 < 8; ++q8) { lg[q8] = *(const f32x4*)(lng + (g) * 128 + bcb + 4 * q8); lb[q8] = *(const f32x4*)(lnb + (g) * 128 + bcb + 4 * q8); } } while (0)
#define GM_LOAD_B(g) do { _Pragma("unroll") for (int kk = 0; kk < 4; ++kk) { const float* wp = sgw + ((size_t)(g) * 128 + mi) * 128 + 32 * kk + 8 * fq; swr[2 * kk] = *(const f32x4*)wp; swr[2 * kk + 1] = *(const f32x4*)(wp + 4); } \
            _Pragma("unroll") for (int mt = 0; mt < 8; ++mt) uvr[mt] = *(const u32x2*)(Tu + (size_t)(tok0 + mi) * 1024 + (g) * 128 + 16 * mt + 4 * fq); \
            bi = sgb[(g) * 128 + mi]; } while (0)
        GM_LOAD_A(g0); GM_LOAD_B(g0);
        LDS_BARRIER();
#pragma unroll 1
        for (int g = g0; g < g0 + 4; ++g) {
            {
                const float mean = st[2 * bj], rstd = st[2 * bj + 1];
#pragma unroll
                for (int q4 = 0; q4 < 4; ++q4) {
                    const unsigned wv[4] = {tvr[q4].x, tvr[q4].y, tvr[q4].z, tvr[q4].w};
#pragma unroll
                    for (int e = 0; e < 4; ++e) {
                        const int cl = q4 * 8 + 2 * e, c = bcb + cl;
                        float ge0, ge1; gelu2(bflo(wv[e]), bfhi(wv[e]), ge0, ge1);
                        const float v0 = (ge0 - mean) * rstd * lg[cl >> 2][cl & 3] + lb[cl >> 2][cl & 3];
                        const float v1 = (ge1 - mean) * rstd * lg[(cl + 1) >> 2][(cl + 1) & 3] + lb[(cl + 1) >> 2][(cl + 1) & 3];
                        const unsigned pw = pk(v0, v1);
                        vgT[c * 136 + bj] = (bf16_t)(pw & 0xffffu); vgT[(c + 1) * 136 + bj] = (bf16_t)(pw >> 16);
                    }
                }
            }
            if (g + 1 < g0 + 4) GM_LOAD_A(g + 1);
            LDS_BARRIER();
            {
                bf16x8 yf[4];
#pragma unroll
                for (int kk = 0; kk < 4; ++kk) {
                    float v[8];
                    const f32x4 a = swr[2 * kk], b2 = swr[2 * kk + 1];
                    v[0] = a[0]; v[1] = a[1]; v[2] = a[2]; v[3] = a[3]; v[4] = b2[0]; v[5] = b2[1]; v[6] = b2[2]; v[7] = b2[3];
#pragma unroll
                    for (int e = 0; e < 8; ++e) v[e] = (32 * kk + 8 * fq + e <= mi) ? v[e] : 0.f;
                    yf[kk] = pack8(v);
                }
#pragma unroll
                for (int mt = 0; mt < 8; ++mt) {
                    f32x4 d = {0.f, 0.f, 0.f, 0.f};
#pragma unroll
                    for (int kk = 0; kk < 4; ++kk) if (kk < nkk) {
                        const bf16x8 xf = *(const LAS bf16x8*)(vgT + (16 * mt + fr) * 136 + 32 * kk + 8 * fq);
                        d = MFMA(xf, yf[kk], d);
                    }
                    const size_t offy = (size_t)(tok0 + mi) * 2048 + g * 128 + 16 * mt + 4 * fq;
                    const u32x2 uv = uvr[mt];
                    float u0, u1, u2, u3; gelu2(bflo(uv.x), bfhi(uv.x), u0, u1); gelu2(bflo(uv.y), bfhi(uv.y), u2, u3);
                    const float r0 = u0 * (d[0] + bi), r1 = u1 * (d[1] + bi), r2 = u2 * (d[2] + bi), r3 = u3 * (d[3] + bi);
                    u32x2 w; w.x = pk(r0, r1); w.y = pk(r2, r3);
                    *(u32x2*)(yb + offy) = w;
                }
            }
            if (g + 1 < g0 + 4) GM_LOAD_B(g + 1);
            LDS_BARRIER();
        }
#undef GM_LOAD_A
#undef GM_LOAD_B
    }
}

__device__ __forceinline__ void conv32L(const bf16_t* xrow, int s, const LAS float* wl, float (&o)[4][8]) {
#pragma unroll
    for (int kk = 0; kk < 4; ++kk)
#pragma unroll
        for (int e = 0; e < 8; ++e) o[kk][e] = 0.f;
#pragma unroll
    for (int rh = 0; rh < 2; ++rh) {
        u32x2 x[2][4][2];
#pragma unroll
        for (int r2 = 0; r2 < 2; ++r2) {
            const int r = 2 * rh + r2;
            const bool ok = (s - r >= 0);
#pragma unroll
            for (int kk = 0; kk < 4; ++kk) {
                const u32x2 a = *(const u32x2*)(xrow - r * 1024 + 32 * kk), bb = *(const u32x2*)(xrow - r * 1024 + 32 * kk + 16);
                x[r2][kk][0] = ok ? a : (u32x2){0u, 0u}; x[r2][kk][1] = ok ? bb : (u32x2){0u, 0u};
            }
        }
#pragma unroll
        for (int kk = 0; kk < 4; ++kk) {
#pragma unroll
            for (int r2 = 0; r2 < 2; ++r2) {
                const int r = 2 * rh + r2;
                const f32x4 w0 = *(const LAS f32x4*)(wl + (3 - r) * 128 + 32 * kk), w1 = *(const LAS f32x4*)(wl + (3 - r) * 128 + 32 * kk + 16);
                const u32x2 x0 = x[r2][kk][0], x1 = x[r2][kk][1];
                o[kk][0] += w0[0] * bflo(x0.x); o[kk][1] += w0[1] * bfhi(x0.x); o[kk][2] += w0[2] * bflo(x0.y); o[kk][3] += w0[3] * bfhi(x0.y);
                o[kk][4] += w1[0] * bflo(x1.x); o[kk][5] += w1[1] * bfhi(x1.x); o[kk][6] += w1[2] * bflo(x1.y); o[kk][7] += w1[3] * bfhi(x1.y);
            }
        }
        asm volatile("" ::: "memory");
    }
#pragma unroll
    for (int kk = 0; kk < 4; ++kk)
#pragma unroll
        for (int e = 0; e < 8; ++e) o[kk][e] = silu_f(o[kk][e]);
}
__device__ __forceinline__ void stage67(const bf16_t* T, int tok0, int s0, int col0, LAS unsigned char* st, int lane) {
    const int rg = lane >> 3, pc = lane & 7;
    u32x4 v[9];
#pragma unroll
    for (int it = 0; it < 9; ++it) {
        const int jr = it * 8 + rg;
        v[it] = (u32x4){0u, 0u, 0u, 0u};
        if (jr < 67 && s0 - 3 + jr >= 0) v[it] = *(const u32x4*)(T + (ptrdiff_t)(tok0 - 3 + jr) * 1024 + col0 + 8 * pc);
    }
#pragma unroll
    for (int it = 0; it < 9; ++it) { const int jr = it * 8 + rg; if (jr < 67) *(LAS u32x4*)(st + jr * 144 + pc * 16) = v[it]; }
}

__device__ __forceinline__ void dn_chunk(KP p, int l, int b, int n, int h, LAS float* Tm  , LAS float* sc  , LAS float* wq  ) {
    const int lane = fresh_tid() & 63, fr = lane & 15, fq = lane >> 4;
    unsigned char* ws = p->ws;
    const bf16_t* Tq = (const bf16_t*)(ws + WS_PROJ);
    const bf16_t* Tk = Tq + SPL; const bf16_t* Tv = Tq + 2 * SPL;
    const float* cw = p->in[3] + (size_t)l * 4 * 3072;
    const int tok0 = b * SEQ + 64 * n, s0 = 64 * n, cid = (b * 8 + h) * 64 + n;
    u32x4* wf = (u32x4*)(ws + WS_WF) + (size_t)cid * 1024;
    u32x4* qdf = (u32x4*)(ws + WS_QDF) + (size_t)cid * 1024;
    u32x4* kdf = (u32x4*)(ws + WS_KDF) + (size_t)cid * 1024;
    u32x4* atf = (u32x4*)(ws + WS_ATTN) + (size_t)cid * 512;
    u32x2* uf = (u32x2*)(ws + WS_UF) + (size_t)cid * 2048;
    LAS float* sgc = sc; LAS float* sbt = sc + 64; LAS float* seg = sc + 128; LAS float* srk = sc + 192;
    LAS float* wk = Tm;

    float gl;
    {
        float gcs = ((const float*)(ws + WS_G))[(size_t)(tok0 + lane) * 8 + h];
        const float bj_own = ((const float*)(ws + WS_BETA))[(size_t)(tok0 + lane) * 8 + h];
        float wqv[8], wkv[8];
#pragma unroll
        for (int i = 0; i < 8; ++i) { const int idx = lane + 64 * i; wqv[i] = cw[(idx >> 7) * 3072 + h * 128 + (idx & 127)]; wkv[i] = cw[(idx >> 7) * 3072 + 1024 + h * 128 + (idx & 127)]; }
#pragma unroll
        for (int o = 1; o < 64; o <<= 1) { const float t = __shfl_up(gcs, o); if (lane >= o) gcs += t; }
        gl = __shfl(gcs, 63);
        sgc[lane] = gcs; sbt[lane] = bj_own; seg[lane] = __expf(gcs);
        if (lane == 0) ((float*)(ws + WS_GL))[cid] = gl;
#pragma unroll
        for (int i = 0; i < 8; ++i) { wq[lane + 64 * i] = wqv[i]; wk[lane + 64 * i] = wkv[i]; }
    }
    LDS_FENCE();

    u32x4* ktmp = kdf;
#pragma unroll 1
    for (int mt = 0; mt < (((DBLC) & 1) ? 8 : 4); ++mt) {
        const int j = 16 * (mt & 3) + fr;
        float kv[4][8]; float ss = 0.f;
        conv32L(Tk + (size_t)(tok0 + j) * 1024 + h * 128 + 4 * fq, s0 + j, wk + 4 * fq, kv);
#pragma unroll
        for (int kk = 0; kk < 4; ++kk)
#pragma unroll
            for (int e = 0; e < 8; ++e) ss += kv[kk][e] * kv[kk][e];
        ss += __shfl_xor(ss, 16); ss += __shfl_xor(ss, 32);
        const float rn = rsqrtf(ss + 1e-6f);
        if (fq == 0) srk[j] = rn;
#pragma unroll
        for (int kk = 0; kk < 4; ++kk) {
#pragma unroll
            for (int e = 0; e < 8; ++e) kv[kk][e] *= rn;
            ktmp[((mt & 3) * 4 + kk) * 64 + lane] = __builtin_bit_cast(u32x4, pack8(kv[kk]));
        }
    }
    asm volatile("s_waitcnt vmcnt(0) lgkmcnt(0)" ::: "memory");
    for (int r = 0; r < 64; ++r) Tm[r * 68 + lane] = 0.f;
    LDS_FENCE();
#pragma unroll 1
    for (int mt2 = 0; mt2 < (((DBLC) & 2) ? 8 : 4); ++mt2) {
        const int mt = mt2 & 3;
        const int i = 16 * mt + fr;
        bf16x8 qf[4], kfm[4];
        {
            float qv[4][8]; float ss = 0.f;
            conv32L(Tq + (size_t)(tok0 + i) * 1024 + h * 128 + 4 * fq, s0 + i, wq + 4 * fq, qv);
#pragma unroll
            for (int kk = 0; kk < 4; ++kk)
#pragma unroll
                for (int e = 0; e < 8; ++e) ss += qv[kk][e] * qv[kk][e];
            ss += __shfl_xor(ss, 16); ss += __shfl_xor(ss, 32);
            const float rn = rsqrtf(ss + 1e-6f) * 0.08838834764831845f;
            const float egi = seg[i];
#pragma unroll
            for (int kk = 0; kk < 4; ++kk) {
                float qd[8];
#pragma unroll
                for (int e = 0; e < 8; ++e) { qv[kk][e] *= rn; qd[e] = qv[kk][e] * egi; }
                qf[kk] = pack8(qv[kk]);
                qdf[(mt * 4 + kk) * 64 + lane] = __builtin_bit_cast(u32x4, pack8(qd));
                kfm[kk] = __builtin_bit_cast(bf16x8, ktmp[(mt * 4 + kk) * 64 + lane]);
            }
        }
        const float gci = sgc[i], bi = sbt[i];
#pragma unroll 1
        for (int k2 = 0; k2 < 2; ++k2) {
            f32x4 at[2];
#pragma unroll
            for (int hf = 0; hf < 2; ++hf) {
                const int nt = 2 * k2 + hf;
                at[hf] = (f32x4){0.f, 0.f, 0.f, 0.f};
                if (nt <= mt) {
                    f32x4 dq = {0.f, 0.f, 0.f, 0.f}, dk = {0.f, 0.f, 0.f, 0.f};
#pragma unroll
                    for (int kk = 0; kk < 4; ++kk) { const bf16x8 kfn = __builtin_bit_cast(bf16x8, ktmp[(nt * 4 + kk) * 64 + lane]); dq = MFMA(kfn, qf[kk], dq); dk = MFMA(kfn, kfm[kk], dk); }
                    const f32x4 gcj = *(const LAS f32x4*)(sgc + 16 * nt + 4 * fq);
                    f32x4 lv;
#pragma unroll
                    for (int jj = 0; jj < 4; ++jj) {
                        const int j = 16 * nt + 4 * fq + jj;
                        const float dec = (j <= i) ? __expf(gci - gcj[jj]) : 0.f;
                        at[hf][jj] = dq[jj] * dec;
                        lv[jj] = (j < i) ? bi * dk[jj] * dec : 0.f;
                    }
                    *(LAS f32x4*)(Tm + i * 68 + 16 * nt + 4 * fq) = lv;
                }
            }
            atf[(mt * 2 + k2) * 64 + lane] = __builtin_bit_cast(u32x4, pack44(at[0], at[1]));
            asm volatile("" ::: "memory");
        }
    }
    asm volatile("s_waitcnt vmcnt(0) lgkmcnt(0)" ::: "memory");
#pragma unroll 1
    for (int i = 0; i < 64; ++i) {
        float acc = (lane == i) ? 1.f : 0.f;
#pragma unroll
        for (int jb = 0; jb < 64; jb += 16) {
            if (jb < i) {
                f32x4 lv[4]; float t[16];
#pragma unroll
                for (int q4 = 0; q4 < 4; ++q4) lv[q4] = *(const LAS f32x4*)(Tm + i * 68 + jb + 4 * q4);
#pragma unroll
                for (int e = 0; e < 16; ++e) t[e] = Tm[(jb + e) * 68 + lane];
#pragma unroll
                for (int e = 0; e < 16; ++e) acc -= lv[e >> 2][e & 3] * t[e];
            }
        }
        LDS_FENCE();
        Tm[i * 68 + lane] = (lane <= i) ? acc : 0.f;
        LDS_FENCE();
    }
    bf16x8 Tf[4][2];
#pragma unroll
    for (int mt = 0; mt < 4; ++mt)
#pragma unroll
        for (int k2 = 0; k2 < 2; ++k2) {
            const f32x4 a = *(const LAS f32x4*)(Tm + (16 * mt + fr) * 68 + 32 * k2 + 4 * fq), bb = *(const LAS f32x4*)(Tm + (16 * mt + fr) * 68 + 32 * k2 + 16 + 4 * fq);
            Tf[mt][k2] = pack44(a, bb);
        }
    LDS_FENCE();
    LAS unsigned char* st = (LAS unsigned char*)Tm;
#pragma unroll 1
    for (int pass2 = 0; pass2 < (((DBLC) & 4) ? 8 : 4); ++pass2) {
        const int pass = pass2 & 3;
        const int isv = pass >> 1, hh = pass & 1;
        if (hh == 0) {
            float wv8[8];
#pragma unroll
            for (int i = 0; i < 8; ++i) { const int idx = lane + 64 * i; wv8[i] = cw[(idx >> 7) * 3072 + 1024 + 1024 * isv + h * 128 + (idx & 127)]; }
#pragma unroll
            for (int i = 0; i < 8; ++i) wq[lane + 64 * i] = wv8[i];
        }
        stage67(isv ? Tv : Tk, tok0, s0, h * 128 + 64 * hh, st, lane);
        LDS_FENCE();
#pragma unroll 1
        for (int c4 = 0; c4 < 4; ++c4) {
            const int ct = 4 * hh + c4, c = 16 * ct + fr;
            float cwx[4];
#pragma unroll
            for (int r = 0; r < 4; ++r) cwx[r] = wq[(3 - r) * 128 + c];
            bf16x8 xbf[2];
#pragma unroll
            for (int k2 = 0; k2 < 2; ++k2) {
                float xb[8], kd[8];
#pragma unroll
                for (int run = 0; run < 2; ++run) {
                    const int jb = 32 * k2 + 16 * run + 4 * fq;
                    float xx[7];
#pragma unroll
                    for (int d = 0; d < 7; ++d) xx[d] = bf2f(*(const LAS bf16_t*)(st + (jb + d) * 144 + (16 * c4 + fr) * 2));
                    const f32x4 rk4 = *(const LAS f32x4*)(srk + jb), bt4 = *(const LAS f32x4*)(sbt + jb), eg4 = *(const LAS f32x4*)(seg + jb), gc4 = *(const LAS f32x4*)(sgc + jb);
#pragma unroll
                    for (int e = 0; e < 4; ++e) {
                        float ax = 0.f;
#pragma unroll
                        for (int r = 0; r < 4; ++r) ax += cwx[r] * xx[3 + e - r];
                        const float sv = silu_f(ax);
                        if (isv) { xb[4 * run + e] = sv * bt4[e]; kd[4 * run + e] = 0.f; }
                        else { const float kn = sv * rk4[e]; xb[4 * run + e] = kn * bt4[e] * eg4[e]; kd[4 * run + e] = kn * __expf(gl - gc4[e]); }
                    }
                }
                xbf[k2] = pack8(xb);
                if (!isv) kdf[(ct * 2 + k2) * 64 + lane] = __builtin_bit_cast(u32x4, pack8(kd));
            }
#pragma unroll
            for (int mt = 0; mt < 4; ++mt) {
                if (isv) {
                    f32x4 d = {0.f, 0.f, 0.f, 0.f};
                    d = MFMA(Tf[mt][0], xbf[0], d); d = MFMA(Tf[mt][1], xbf[1], d);
                    u32x2 w; w.x = pk(d[0], d[1]); w.y = pk(d[2], d[3]);
                    uf[(ct * 4 + mt) * 64 + lane] = w;
                } else {
                    f32x4 e2 = {0.f, 0.f, 0.f, 0.f};
                    e2 = MFMA(xbf[0], Tf[mt][0], e2); e2 = MFMA(xbf[1], Tf[mt][1], e2);
                    u32x2 w2; w2.x = pk(-e2[0], -e2[1]); w2.y = pk(-e2[2], -e2[3]);
                    ((u32x2*)wf)[((mt * 4 + (ct >> 1)) * 64 + lane) * 2 + (ct & 1)] = w2;
                }
            }
        }
        LDS_FENCE();
    }
}

__device__ __forceinline__ void dn_chunk_phase(KP p, int l, LAS unsigned char* lds) {
    const int wave = fresh_tid() >> 6, G = gridDim.x;
    LAS float* Tm = (LAS float*)(lds + wave * 20480);
    LAS float* sc = (LAS float*)(lds + wave * 20480 + 17408);
    LAS float* wq = (LAS float*)(lds + wave * 20480 + 18432);
    for (int it = blockIdx.x; it < 256; it += G) dn_chunk(p, l, it >> 6, it & 63, wave, Tm, sc, wq);
}

constexpr int SCA_BUF = 34816, SCB_BUF = 24576, SCX_BUF = 6144;
constexpr int SCA_OFF = 0, SCB_OFF = 2 * SCA_BUF, SCX_OFF = SCB_OFF + 3 * SCB_BUF, SC_NCH = (SCA_BUF + SCB_BUF) / 16, SCA_NCH = SCA_BUF / 16;
__device__ __forceinline__ const u32x4* sc_src(unsigned char* ws, int cid, int sl, int i) {
    if (i < 1024) return (const u32x4*)(ws + WS_WF) + (size_t)cid * 1024 + i;
    if (i < 2048) return (const u32x4*)(ws + WS_KDF) + (size_t)cid * 1024 + (i - 1024);
    if (i < 2176) return (const u32x4*)(ws + WS_UF) + (size_t)cid * 1024 + sl * 128 + (i - 2048);
    if (i < 3200) return (const u32x4*)(ws + WS_QDF) + (size_t)cid * 1024 + (i - 2176);
    return (const u32x4*)(ws + WS_ATTN) + (size_t)cid * 512 + (i - 3200);
}
__device__ __forceinline__ void dn_scan_phase(KP p, LAS unsigned char* lds) {
    const int tid = fresh_tid(), lane = tid & 63, wave = __builtin_amdgcn_readfirstlane(tid >> 6), fr = lane & 15, fq = lane >> 4, G = gridDim.x;
    unsigned char* ws = p->ws;
    for (int c = blockIdx.x; c < 256; c += G) {
        const int xcd = c & 7, idx = c >> 3, sl = idx & 7, bh = xcd * 4 + (idx >> 3), b = bh >> 3, h = bh & 7;
        if (wave >= 2) {
            const int pt = tid - 128;
            u32x4 R0[10], R1[10];
#define SC_LOAD(R, step) do { const int st_ = (step) < 63 ? (step) : 63; _Pragma("unroll") for (int r = 0; r < 10; ++r) { int i = pt + 384 * r; i = i < SC_NCH ? i : SC_NCH - 1; R[r] = *sc_src(ws, bh * 64 + st_, sl, i); } } while (0)
#define SC_STORE(R, step) do { LAS unsigned char* wa = lds + SCA_OFF + ((step) & 1) * SCA_BUF; LAS unsigned char* wb = lds + SCB_OFF + ((step) % 3) * SCB_BUF - SCA_NCH * 16; \
        _Pragma("unroll") for (int r = 0; r < 9; ++r) { const int i = pt + 384 * r; LAS unsigned char* d = (i < SCA_NCH) ? wa + i * 16 : wb + i * 16; *(LAS u32x4*)d = R[r]; } \
        if (pt + 384 * 9 < SC_NCH) *(LAS u32x4*)(wb + (pt + 384 * 9) * 16) = R[9]; } while (0)
            SC_LOAD(R0, 0); SC_LOAD(R1, 1);
            SC_STORE(R0, 0);
            SC_LOAD(R0, 2);
            LDS_BARRIER();
#pragma unroll 1
            for (int n = 0; n < 64; n += 2) {
                SC_STORE(R1, n + 1); SC_LOAD(R1, n + 3); LDS_BARRIER();
                SC_STORE(R0, n + 2); SC_LOAD(R0, n + 4); LDS_BARRIER();
            }
            LDS_BARRIER();
#undef SC_LOAD
#undef SC_STORE
        } else if (wave == 0) {
            f32x4 S[8]; bf16x8 Sf[4];
            const float glv = ((const float*)(ws + WS_GL))[bh * 64 + lane];
#pragma unroll
            for (int m = 0; m < 8; ++m) S[m] = (f32x4){0.f, 0.f, 0.f, 0.f};
#pragma unroll
            for (int k = 0; k < 4; ++k) Sf[k] = (bf16x8){0, 0, 0, 0, 0, 0, 0, 0};
#define SC_STEP_A(n) do { \
            const LAS unsigned char* ra = lds + SCA_OFF + ((n) & 1) * SCA_BUF + lane * 16; \
            LAS unsigned char* xw = lds + SCX_OFF + ((n) & 1) * SCX_BUF + lane * 16; \
            _Pragma("unroll") for (int kk = 0; kk < 4; ++kk) *(LAS bf16x8*)(xw + kk * 1024) = Sf[kk]; \
            const float egl = __expf(__shfl(glv, (n))); \
            f32x4 vn[4]; \
            _Pragma("unroll") for (int mt = 0; mt < 4; ++mt) { \
                const u32x2 uu = *(const LAS u32x2*)(lds + SCA_OFF + ((n) & 1) * SCA_BUF + 32768 + (mt * 64 + lane) * 8); \
                f32x4 a = {bflo(uu.x), bfhi(uu.x), bflo(uu.y), bfhi(uu.y)}; \
                _Pragma("unroll") for (int kk = 0; kk < 4; ++kk) a = MFMA(*(const LAS bf16x8*)(ra + (mt * 4 + kk) * 1024), Sf[kk], a); \
                vn[mt] = a; } \
            bf16x8 Vf[2]; Vf[0] = pack44(vn[0], vn[1]); Vf[1] = pack44(vn[2], vn[3]); \
            *(LAS bf16x8*)(xw + 4096) = Vf[0]; *(LAS bf16x8*)(xw + 5120) = Vf[1]; \
            _Pragma("unroll") for (int mt = 0; mt < 8; ++mt) { \
                f32x4 a = S[mt] * egl; \
                a = MFMA(*(const LAS bf16x8*)(ra + 16384 + (mt * 2 + 0) * 1024), Vf[0], a); a = MFMA(*(const LAS bf16x8*)(ra + 16384 + (mt * 2 + 1) * 1024), Vf[1], a); \
                S[mt] = a; } \
            _Pragma("unroll") for (int kk = 0; kk < 4; ++kk) Sf[kk] = pack44(S[2 * kk], S[2 * kk + 1]); \
        } while (0)
            LDS_BARRIER();
#pragma unroll 1
            for (int n = 0; n < 64; n += 2) {
                SC_STEP_A(n); LDS_BARRIER();
                SC_STEP_A(n + 1); LDS_BARRIER();
            }
            LDS_BARRIER();
#undef SC_STEP_A
        } else {
            bf16_t* ob = (bf16_t*)(ws + WS_O);
#define SC_STEP_B(m1) do { \
            const LAS unsigned char* rb = lds + SCB_OFF + ((m1) % 3) * SCB_BUF + lane * 16; \
            const LAS unsigned char* xr = lds + SCX_OFF + ((m1) & 1) * SCX_BUF + lane * 16; \
            bf16x8 Sg[4], Vg[2]; \
            _Pragma("unroll") for (int kk = 0; kk < 4; ++kk) Sg[kk] = *(const LAS bf16x8*)(xr + kk * 1024); \
            Vg[0] = *(const LAS bf16x8*)(xr + 4096); Vg[1] = *(const LAS bf16x8*)(xr + 5120); \
            const int tokb = b * SEQ + 64 * (m1); \
            _Pragma("unroll") for (int mt = 0; mt < 4; ++mt) { \
                f32x4 a = {0.f, 0.f, 0.f, 0.f}; \
                _Pragma("unroll") for (int kk = 0; kk < 4; ++kk) a = MFMA(*(const LAS bf16x8*)(rb + (mt * 4 + kk) * 1024), Sg[kk], a); \
                a = MFMA(*(const LAS bf16x8*)(rb + 16384 + (mt * 2 + 0) * 1024), Vg[0], a); a = MFMA(*(const LAS bf16x8*)(rb + 16384 + (mt * 2 + 1) * 1024), Vg[1], a); \
                _Pragma("unroll") for (int jj = 0; jj < 4; ++jj) ob[(size_t)(tokb + 16 * mt + 4 * fq + jj) * 1024 + h * 128 + sl * 16 + fr] = (bf16_t)(pk(a[jj], 0.f) & 0xffffu); } \
        } while (0)
            LDS_BARRIER();
#pragma unroll 1
            for (int n = 0; n < 64; n += 2) {
                if (n >= 1) SC_STEP_B(n - 1);
                LDS_BARRIER();
                SC_STEP_B(n); LDS_BARRIER();
            }
            SC_STEP_B(63);
            LDS_BARRIER();
#undef SC_STEP_B
        }
    }
}

__device__ __forceinline__ void ya_phase(KP p, int l) {
    const int lane = fresh_tid() & 63, wave = fresh_tid() >> 6, G = gridDim.x;
    const bf16_t* ob = (const bf16_t*)(p->ws + WS_O);
    const bf16_t* Tz = (const bf16_t*)(p->ws + WS_PROJ) + 3 * SPL;
    bf16_t* ya = (bf16_t*)(p->ws + WS_Y);
    float ogv[16];
    { const float* og = p->in[6] + (size_t)l * 128 + (lane & 7) * 16;
#pragma unroll
      for (int e = 0; e < 4; ++e) { const f32x4 t = *(const f32x4*)(og + 4 * e); ogv[4 * e] = t[0]; ogv[4 * e + 1] = t[1]; ogv[4 * e + 2] = t[2]; ogv[4 * e + 3] = t[3]; } }
    const int stride = G * 8;
    for (int row0 = blockIdx.x * 8 + wave; row0 < NTOK; row0 += 4 * stride) {
        u32x4 oa[4], obb[4], za[4], zb[4];
#pragma unroll
        for (int q = 0; q < 4; ++q) {
            const int row = row0 + q * stride;
            if (row < NTOK) { const size_t off = (size_t)row * 1024 + lane * 16;
                oa[q] = *(const u32x4*)(ob + off); obb[q] = *(const u32x4*)(ob + off + 8); za[q] = *(const u32x4*)(Tz + off); zb[q] = *(const u32x4*)(Tz + off + 8); }
        }
#pragma unroll
        for (int q = 0; q < 4; ++q) {
            const int row = row0 + q * stride;
            if (row < NTOK) {
                const unsigned ov[8] = {oa[q].x, oa[q].y, oa[q].z, oa[q].w, obb[q].x, obb[q].y, obb[q].z, obb[q].w}, zv[8] = {za[q].x, za[q].y, za[q].z, za[q].w, zb[q].x, zb[q].y, zb[q].z, zb[q].w};
                float o[16]; float ss = 0.f;
#pragma unroll
                for (int e = 0; e < 8; ++e) { o[2 * e] = bflo(ov[e]); o[2 * e + 1] = bfhi(ov[e]); ss += o[2 * e] * o[2 * e] + o[2 * e + 1] * o[2 * e + 1]; }
                ss += __shfl_xor(ss, 1); ss += __shfl_xor(ss, 2); ss += __shfl_xor(ss, 4);
                const float rstd = rsqrtf(ss * (1.f / 128.f) + 1e-6f);
                unsigned w[8];
#pragma unroll
                for (int e = 0; e < 8; ++e) {
                    const float r0 = o[2 * e] * rstd * ogv[2 * e] * silu_f(bflo(zv[e])), r1 = o[2 * e + 1] * rstd * ogv[2 * e + 1] * silu_f(bfhi(zv[e]));
                    w[e] = pk(r0, r1);
                }
                const size_t offy = (size_t)row * 2048 + lane * 16;
                *(u32x4*)(ya + offy) = (u32x4){w[0], w[1], w[2], w[3]}; *(u32x4*)(ya + offy + 8) = (u32x4){w[4], w[5], w[6], w[7]};
            }
        }
    }
}

__device__ __forceinline__ void ffn_act_phase(KP p, int l) {
    const bf16_t* gu = (const bf16_t*)(p->ws + WS_GU);
    bf16_t* hid = (bf16_t*)(p->ws + WS_HID);
    const float* cw = p->in[17] + (size_t)l * 3 * FF; const float* cb = p->in[18] + (size_t)l * FF;
    const int nitem = (NTOK / 8) * (FF / 8);
    for (int it = blockIdx.x * 512 + fresh_tid(); it < nitem; it += gridDim.x * 512) {
        const int cb8 = it % (FF / 8), tb = it / (FF / 8), c0 = cb8 * 8, t0 = tb * 8;
        float w0[8], w1[8], w2[8], bb[8];
#pragma unroll
        for (int e = 0; e < 8; ++e) { w0[e] = cw[c0 + e]; w1[e] = cw[FF + c0 + e]; w2[e] = cw[2 * FF + c0 + e]; bb[e] = cb[c0 + e]; }
        float g2[8], g1[8];
        const bool first = (t0 % SEQ) == 0;
        {
            u32x4 a = {0u, 0u, 0u, 0u}, b = {0u, 0u, 0u, 0u};
            if (!first) { a = *(const u32x4*)(gu + (size_t)(t0 - 2) * (2 * FF) + c0); b = *(const u32x4*)(gu + (size_t)(t0 - 1) * (2 * FF) + c0); }
            const unsigned av[4] = {a.x, a.y, a.z, a.w}, bv[4] = {b.x, b.y, b.z, b.w};
#pragma unroll
            for (int e = 0; e < 4; ++e) { g2[2 * e] = bflo(av[e]); g2[2 * e + 1] = bfhi(av[e]); g1[2 * e] = bflo(bv[e]); g1[2 * e + 1] = bfhi(bv[e]); }
        }
#pragma unroll
        for (int tt = 0; tt < 8; ++tt) {
            const u32x4 a = *(const u32x4*)(gu + (size_t)(t0 + tt) * (2 * FF) + c0), u = *(const u32x4*)(gu + (size_t)(t0 + tt) * (2 * FF) + FF + c0);
            const unsigned av[4] = {a.x, a.y, a.z, a.w}, uv[4] = {u.x, u.y, u.z, u.w};
            float g0[8], r[8];
#pragma unroll
            for (int e = 0; e < 4; ++e) { g0[2 * e] = bflo(av[e]); g0[2 * e + 1] = bfhi(av[e]); }
#pragma unroll
            for (int e = 0; e < 8; ++e) {
                const float gt = w0[e] * g2[e] + w1[e] * g1[e] + w2[e] * g0[e] + bb[e];
                const float up = (e & 1) ? bfhi(uv[e >> 1]) : bflo(uv[e >> 1]);
                r[e] = silu_f(gt) * up;
                g2[e] = g1[e]; g1[e] = g0[e];
            }
            *(u32x4*)(hid + (size_t)(t0 + tt) * FF + c0) = (u32x4){pk(r[0], r[1]), pk(r[2], r[3]), pk(r[4], r[5]), pk(r[6], r[7])};
        }
    }
}

#define XB_TMO      128
#define XB_XCNT(j)  (256  + 64 * (j))
#define XB_XSUB(j)  (1280 + 64 * (j))
#define XB_XGEN(j)  (2304 + 64 * (j))
#define XB_TOP      3328
#define XB_TOPGEN   3392
#define XCD_BAR_WORDS 3456
#define XB_SPIN_CAP (1u << 20)
__device__ unsigned g_bar[XCD_BAR_WORDS];
__device__ __forceinline__ unsigned xb_ld(unsigned* p)              { return __hip_atomic_load(p, __ATOMIC_RELAXED, __HIP_MEMORY_SCOPE_AGENT); }
__device__ __forceinline__ unsigned xb_add(unsigned* p, unsigned v) { return __hip_atomic_fetch_add(p, v, __ATOMIC_RELAXED, __HIP_MEMORY_SCOPE_AGENT); }
__device__ __forceinline__ unsigned xb_xcc_id() { return (unsigned)__builtin_amdgcn_s_getreg((3 << 11) | 20) & 0xFu; }
#define XB_SPIN(cond, bar) do { unsigned _sp = 0; while (cond) { __builtin_amdgcn_s_sleep(1); \
    if ((++_sp & 255u) == 0u) { if (xb_ld(&(bar)[XB_TMO])) break; if (_sp > XB_SPIN_CAP) { atomicAdd(&(bar)[XB_TMO], 1u); break; } } } } while (0)
struct XB { unsigned x, nloc, nx; };
__device__ __forceinline__ void xb_complete(unsigned* bar, unsigned x, unsigned& nloc, unsigned& nx) {
    const unsigned G = gridDim.x;
    unsigned sum, cnt, mine, sp = 0u;
    for (;;) {
        sum = 0u; cnt = 0u; mine = 0u;
#pragma unroll
        for (unsigned j = 0; j < 16; ++j) { const unsigned c = xb_ld(&bar[XB_XCNT(j)]); sum += c; cnt += (c > 0u) ? 1u : 0u; mine = (j == x) ? c : mine; }
        if (sum == G) break;
        __builtin_amdgcn_s_sleep(1);
        if ((++sp & 255u) == 0u) { if (xb_ld(&bar[XB_TMO])) break; if (sp > XB_SPIN_CAP) { atomicAdd(&bar[XB_TMO], 1u); break; } }
    }
    nloc = mine > 0u ? mine : 1u; nx = cnt > 0u ? cnt : 1u;
}
__device__ __forceinline__ void xcd_barrier(XB& b) {
    asm volatile("s_waitcnt vmcnt(0) lgkmcnt(0)" ::: "memory");
    __syncthreads();
    if (fresh_tid() == 0) {
        unsigned* bar = g_bar;
        __builtin_amdgcn_s_waitcnt(0);
        unsigned nloc = b.nloc, nx = b.nx;
        if (nloc == 0u) { xb_complete(bar, b.x, nloc, nx); b.nloc = nloc; b.nx = nx; }
        const unsigned old = xb_add(&bar[XB_XSUB(b.x)], 1u);
        const unsigned gen = old / nloc;
        if (old + 1u == (gen + 1u) * nloc) {
            __builtin_amdgcn_fence(__ATOMIC_RELEASE, "agent");
            asm volatile("s_waitcnt vmcnt(0)" ::: "memory");
            const unsigned og = xb_add(&bar[XB_TOP], 1u);
            const unsigned tg = og / nx;
            if (og + 1u == (tg + 1u) * nx) xb_add(&bar[XB_TOPGEN], 1u);
            else XB_SPIN(xb_ld(&bar[XB_TOPGEN]) == tg, bar);
            __builtin_amdgcn_fence(__ATOMIC_ACQUIRE, "agent");
            xb_add(&bar[XB_XGEN(b.x)], 1u);
            asm volatile("s_waitcnt vmcnt(0)" ::: "memory");
        } else {
            XB_SPIN(xb_ld(&bar[XB_XGEN(b.x)]) == gen, bar);
            __builtin_amdgcn_fence(__ATOMIC_ACQUIRE, "agent");
            asm volatile("s_waitcnt vmcnt(0)" ::: "memory");
        }
    }
    __syncthreads();
}

constexpr int PH_PER_LAYER = 11, PH_TOTAL = 2 * PH_PER_LAYER + 1;
__global__ void __launch_bounds__(512, 2) mega(Params pa) {
    extern __shared__ __attribute__((aligned(16))) unsigned char lds_raw[];
    LAS unsigned char* lds = (LAS unsigned char*)lds_raw;
    cg::grid_group grid = cg::this_grid();
    const int ph_lo = pa.ph_lo, ph_hi = pa.ph_hi;
#define GSYNC() do { asm volatile("s_waitcnt vmcnt(0) lgkmcnt(0)" ::: "memory"); grid.sync(); if (fresh_tid() < 64) { __builtin_amdgcn_fence(__ATOMIC_ACQUIRE, "agent"); asm volatile("s_waitcnt vmcnt(0)" ::: "memory"); } __syncthreads(); } while (0)
#ifndef DBL_MASK
#define DBL_MASK 0
#endif
#define NREP(bit) (((DBL_MASK) >> (bit)) & 1 ? 2 : 1)
#define RUN(k) (ph_lo <= (k) && (k) < ph_hi)
#define SEAM(k) do { if (RUN(k) && RUN((k) + 1)) { xcd_barrier(xb); } } while (0)
    XB xb; xb.x = xb_xcc_id(); xb.nloc = 0u; xb.nx = 0u;
    if (blockIdx.x == 0) for (int i = fresh_tid(); i < XCD_BAR_WORDS; i += 512) g_bar[i] = 0u;
    GSYNC();
    if (fresh_tid() == 0) (void)xb_add(&g_bar[XB_XCNT(xb.x)], 1u);
#pragma unroll 1
    for (int l0 = 0; l0 < NL; ++l0) {
        const int pb = l0 * PH_PER_LAYER;
        for (int rp = 0; rp < NREP(0); ++rp) { __syncthreads(); if (RUN(pb + 0)) { KP p = get_kp(); const int l = launder_i(l0); xpose_phase(p, l, (LAS float*)lds); __syncthreads(); } }
        for (int rp = 0; rp < NREP(1); ++rp) { __syncthreads(); if (RUN(pb + 0)) { KP p = get_kp(); const int l = launder_i(l0); norm1_phase(p, l, (LAS float*)lds); } }
        SEAM(pb + 0);
        for (int rp = 0; rp < NREP(8); ++rp) { __syncthreads();
        if (RUN(pb + 1)) { KP p = get_kp(); unsigned char* ws = p->ws; const int G = gridDim.x, bid = blockIdx.x;
            pg8::Gemm g{(const bf16_t*)(ws + WS_H), (const bf16_t*)(ws + WS_WIN), NTOK, NIN, DM}; pg8::StaticOrder S; S.init(NTOK, NIN, G, bid);
            pg8::EpiBf16<0> E{(bf16_t*)(ws + WS_PROJ), 1024, nullptr, 1024, SPL};
            pg8::gemm_phase<pg8::EpiBf16<0>, pg8::StaticOrder, false, GEMM_ALIGN, GEMM_SP2>(lds, g, S, E, nullptr);
        }
         }
        SEAM(pb + 1);
        for (int rp = 0; rp < NREP(2); ++rp) { __syncthreads(); if (RUN(pb + 2)) { KP p = get_kp(); const int l = launder_i(l0); gmlp_phase(p, l, lds); __syncthreads(); } }
        for (int rp = 0; rp < NREP(3); ++rp) { __syncthreads(); if (RUN(pb + 2)) { KP p = get_kp(); const int l = launder_i(l0); dn_chunk_phase(p, l, lds); } }
        SEAM(pb + 2);
        for (int rp = 0; rp < NREP(4); ++rp) { __syncthreads(); if (RUN(pb + 3)) { KP p = get_kp(); dn_scan_phase(p, lds); } }
        SEAM(pb + 3);
        for (int rp = 0; rp < NREP(5); ++rp) { __syncthreads(); if (RUN(pb + 4)) { KP p = get_kp(); const int l = launder_i(l0); ya_phase(p, l); } }
        SEAM(pb + 4);
        if (RUN(pb + 5)) { KP p = get_kp(); unsigned char* ws = p->ws; const int G = gridDim.x, bid = blockIdx.x;
            pg8::Gemm g{(const bf16_t*)(ws + WS_Y), (const bf16_t*)(ws + WS_WA), NTOK, DM, 1024, 2048}; PairOrder S; S.S.init(NTOK, DM, G, bid);
            EpiMerge E{(const bf16_t*)(ws + WS_PROJ) + 6 * SPL, (const bf16_t*)(ws + WS_PROJ) + 8 * SPL, (bf16_t*)(ws + WS_MRG)};
            pg8::gemm_phase<EpiMerge, PairOrder, false, GEMM_ALIGN, GEMM_SP2>(lds, g, S, E, nullptr); }
        SEAM(pb + 5);
        if (RUN(pb + 6)) { KP p = get_kp(); unsigned char* ws = p->ws; const int G = gridDim.x, bid = blockIdx.x; const int l = launder_i(l0);
            pg8::Gemm g{(const bf16_t*)(ws + WS_MRG), (const bf16_t*)(ws + WS_WOUT), NTOK, DM, DM}; pg8::StaticOrder S; S.init(NTOK, DM, G, bid);
            EpiRes E{(l == 0) ? p->in[0] : (const float*)p->out, p->out};
            pg8::gemm_phase<EpiRes, pg8::StaticOrder, false, GEMM_ALIGN, GEMM_SP2>(lds, g, S, E, nullptr);
        }
        SEAM(pb + 6);
        for (int rp = 0; rp < NREP(6); ++rp) { __syncthreads(); if (RUN(pb + 7)) { KP p = get_kp(); const int l = launder_i(l0); norm_phase<false>(p->out, p->in[14] + (size_t)l * DM, (bf16_t*)(p->ws + WS_H2), nullptr); } }
        SEAM(pb + 7);
        if (RUN(pb + 8)) { KP p = get_kp(); unsigned char* ws = p->ws; const int G = gridDim.x, bid = blockIdx.x; const int l = launder_i(l0);
            pg8::Gemm g{(const bf16_t*)(ws + WS_H2), (const bf16_t*)(ws + WS_WGU), NTOK, 2 * FF, DM}; pg8::StaticOrder S; S.init(NTOK, 2 * FF, G, bid);
            EpiFfn E{(bf16_t*)(ws + WS_HID), p->in[17] + (size_t)l * 3 * FF, p->in[18] + (size_t)l * FF, (float*)(ws + WS_HALO), (float*)(ws + WS_FIXG), (float*)(ws + WS_FIXU)};
            pg8::gemm_phase<EpiFfn, pg8::StaticOrder, false, false, GEMM_SP2>(lds, g, S, E, nullptr);
        }
        SEAM(pb + 8);
        for (int rp = 0; rp < NREP(7); ++rp) { __syncthreads(); if (RUN(pb + 9)) { KP p = get_kp(); const int l = launder_i(l0); ffn_fix_phase(p, l); } }
        SEAM(pb + 9);
        if (RUN(pb + 10)) { KP p = get_kp(); unsigned char* ws = p->ws; const int G = gridDim.x, bid = blockIdx.x;
            pg8::Gemm g{(const bf16_t*)(ws + WS_HID), (const bf16_t*)(ws + WS_WD), NTOK, DM, FF}; pg8::StaticOrder S; S.init(NTOK, DM, G, bid);
            EpiRes E{(const float*)p->out, p->out};
            pg8::gemm_phase<EpiRes, pg8::StaticOrder, false, GEMM_ALIGN, GEMM_SP2>(lds, g, S, E, nullptr);
        }
        SEAM(pb + 10);
    }
    if (pa.dbg) { KP p = get_kp(); unsigned char* ws = p->ws; float* out = p->out;
        GSYNC();
        const size_t NH = (size_t)NTOK * 1024;
        for (size_t i = (size_t)blockIdx.x * 512 + fresh_tid(); i < NH; i += (size_t)gridDim.x * 512) {
            float a = 0.f, b = 0.f;
            if (pa.dbg == 1) { a = bf2f(((const bf16_t*)(ws + WS_WF))[i]) + bf2f(((const bf16_t*)(ws + WS_KDF))[i]); b = bf2f(((const bf16_t*)(ws + WS_QDF))[i]) + bf2f(((const bf16_t*)(ws + WS_UF))[i]); }
            if (pa.dbg == 2) { a = (i < NH / 2) ? bf2f(((const bf16_t*)(ws + WS_ATTN))[i]) : ((i - NH / 2 < 2048) ? ((const float*)(ws + WS_GL))[i - NH / 2] : 0.f); b = (i < 262144) ? ((const float*)(ws + WS_BETA))[i] + ((const float*)(ws + WS_G))[i] : 0.f; }
            if (pa.dbg == 3) { a = bf2f(((const bf16_t*)(ws + WS_O))[i]); b = bf2f(((const bf16_t*)(ws + WS_Y))[i]); }
            if (!(fabsf(a) < 1e30f)) a = 12345.f; if (!(fabsf(b) < 1e30f)) b = 12345.f;
            out[i] = a; out[NH + i] = b;
        }
        return; }
    if (RUN(PH_TOTAL - 1)) { KP p = get_kp(); norm_phase<true>(p->out, p->in[20], nullptr, p->out); }
#undef RUN
#undef SEAM
}
}

#ifndef DBG_MODE
#define DBG_MODE 0
#define DBG_HI mk::PH_TOTAL
#endif
extern "C" void kernel_launch(void* const* d_in, const int* in_sizes, int n_in, void* d_out, int out_size, void* d_ws, size_t ws_size, hipStream_t stream) {
    static int grid = 0;
    if (grid == 0) {
        if (n_in != 21 || ws_size < mk::WS_END) { fprintf(stderr, "kernel_launch: need 21 inputs and >= %zu bytes of workspace; got %d, %zu\n", (size_t)mk::WS_END, n_in, ws_size); grid = -1; return; }
        int dev = 0, cus = 0, per_cu = 0;
        hipGetDevice(&dev);
        hipDeviceGetAttribute(&cus, hipDeviceAttributeMultiprocessorCount, dev);
        if (hipFuncSetAttribute((const void*)mk::mega, hipFuncAttributeMaxDynamicSharedMemorySize, mk::LDS_BYTES) != hipSuccess) { fprintf(stderr, "kernel_launch: hipFuncSetAttribute failed\n"); grid = -1; return; }
        if (hipOccupancyMaxActiveBlocksPerMultiprocessor(&per_cu, (const void*)mk::mega, 512, mk::LDS_BYTES) != hipSuccess || per_cu < 1) { fprintf(stderr, "kernel_launch: occupancy query says %d\n", per_cu); per_cu = 1; }
        (void)hipGetLastError();
        grid = cus * 1;
    }
    if (grid < 0) return;
    mk::Params p{};
    for (int i = 0; i < 21; ++i) p.in[i] = (const float*)d_in[i];
    p.out = (float*)d_out; p.ws = (unsigned char*)d_ws; p.ph_lo = 0; p.ph_hi = DBG_HI; p.dbg = DBG_MODE;
    void* args[] = {&p};
    hipError_t e = hipLaunchCooperativeKernel((const void*)mk::mega, dim3(grid), dim3(512), args, mk::LDS_BYTES, stream);
    if (e != hipSuccess) fprintf(stderr, "cooperative launch failed: %s (grid %d)\n", hipGetErrorString(e), grid);
}
```

```cpp
#include <hip/hip_runtime.h>
#include <hip/hip_cooperative_groups.h>
#include <cstdio>
namespace cg = cooperative_groups;
__device__ __forceinline__ int fresh_tid() { int t = threadIdx.x; asm volatile("" : "+v"(t)); return t; }
namespace pg8 {
#define PG8_LAS __attribute__((address_space(3)))
typedef unsigned short bf16_t;
typedef short bf16x8 __attribute__((ext_vector_type(8)));
typedef float f32x4 __attribute__((ext_vector_type(4)));
typedef unsigned u32x4 __attribute__((ext_vector_type(4)));
constexpr int BM = 256, BK = 64, HALF = 128, HTB = HALF * BK * 2  , STAGE_BYTES = 8 * HTB, NXCD = 8, WGM = 8;

__host__ __device__ __forceinline__ int lds_byte(int r, int c) { const int st = (r >> 4) * 2 + (c >> 5), rr = r & 15, cc = c & 31, ob = rr * 64 + cc * 2; return st * 1024 + (ob ^ (((ob >> 9) & 1) << 5)); }
__host__ __device__ __forceinline__ void stage_rc(int b, int& R, int& C) { const int st = b / 1024, sb = b % 1024, swz = sb ^ (((sb >> 9) & 1) << 5); R = (st >> 1) * 16 + swz / 64; C = (st & 1) * 32 + (swz % 64) / 2; }
__host__ __device__ __forceinline__ int perm32(int rho) { const int n = rho >> 4, i = rho & 15; return 8 * (i >> 2) + 4 * n + (i & 3); }

struct Unit { int pm, pn, kh; };
struct Gemm { const bf16_t* A; const bf16_t* Bt; int M, N, K, ld; };

struct StaticOrder {
    int nM, nN, nwg, G, c;
    __host__ __device__ void init(int M, int N, int G_, int c_) { nM = M / BM; nN = N / BM; nwg = nM * nN; G = G_; c = c_; }
    __host__ __device__ __forceinline__ bool next(int i, Unit& u) const {
        const long L = (long)i * G + c; if (L >= nwg) return false;
        int wgid = (int)L; { const int q = nwg / NXCD, r = nwg % NXCD, xcd = wgid % NXCD, off = wgid / NXCD; wgid = (xcd < r ? xcd * (q + 1) : r * (q + 1) + (xcd - r) * q) + off; }
        const int nig = WGM * nN, gid = wgid / nig, fm = gid * WGM, gsz = (nM - fm) < WGM ? (nM - fm) : WGM;
        u.pm = fm + ((wgid % nig) % gsz); u.pn = (wgid % nig) / gsz; u.kh = 0; return true;
    }
    __device__ __forceinline__ void a_ready(const Unit&) const {}
    __device__ __forceinline__ void done(const Unit&) const {}
};
__device__ __forceinline__ unsigned cvt_pk_bf16(float lo, float hi) { unsigned r; asm volatile("v_cvt_pk_bf16_f32 %0, %1, %2" : "=v"(r) : "v"(lo), "v"(hi)); return r; }
typedef float f32x2 __attribute__((ext_vector_type(2)));
__device__ __forceinline__ f32x2 gelu_pk(f32x2 v) {
    const f32x2 av = __builtin_elementwise_abs(v), d = av * 0.2316418882f + 1.0f;
    f32x2 t; t.x = __builtin_amdgcn_rcpf(d.x); t.y = __builtin_amdgcn_rcpf(d.y);
    f32x2 q = t * 0.5307027145f + (-0.7265760135f); q = q * t + 0.7107068705f; q = q * t + (-0.142248368f); q = q * t + 0.127414796f; q = q * t;
    const f32x2 s = (v * v) * (-0.72134752044f);
    f32x2 e; e.x = __builtin_amdgcn_exp2f(s.x); e.y = __builtin_amdgcn_exp2f(s.y);
    const f32x2 m = v * (q * e), r = v - m;
    f32x2 o; o.x = v.x < 0.f ? m.x : r.x; o.y = v.y < 0.f ? m.y : r.y; return o;
}

struct EpiF32 {
    static constexpr bool PERM = false, AFTER_DRAIN = false, SPLITK = false;
    float* C; int ldc; const float* bias;
    __device__ __forceinline__ void operator()(const f32x4 (&acc)[2][2][4][2], const Unit& u, int wr, int wc, int fr, int fq) const {
        const int row0 = u.pm * BM + wr * 64 + fr, col0 = u.pn * BM + wc * 32 + 4 * fq;
        f32x4 bv[2][2];
#pragma unroll
        for (int bj = 0; bj < 2; ++bj)
#pragma unroll
            for (int n = 0; n < 2; ++n) bv[bj][n] = bias ? *(const f32x4*)(bias + col0 + bj * HALF + n * 16) : (f32x4){0.f, 0.f, 0.f, 0.f};
#pragma unroll
        for (int ai = 0; ai < 2; ++ai)
#pragma unroll
            for (int m = 0; m < 4; ++m) { float* rowp = C + (size_t)(row0 + ai * HALF + m * 16) * ldc + col0;
#pragma unroll
                for (int bj = 0; bj < 2; ++bj)
#pragma unroll
                    for (int n = 0; n < 2; ++n) *(f32x4*)(rowp + bj * HALF + n * 16) = acc[ai][bj][m][n] + bv[bj][n]; }
    }
};
template <int ACT  > struct EpiBf16 {
    static constexpr bool PERM = true, AFTER_DRAIN = false, SPLITK = false;
    bf16_t* O; int ldc; const float* bias; int split_cols; size_t split_stride;
    __device__ __forceinline__ void operator()(const f32x4 (&acc)[2][2][4][2], const Unit& u, int wr, int wc, int fr, int fq) const {
        const int row0 = u.pm * BM + wr * 64 + fr; int colt = u.pn * BM; bf16_t* base = O;
        if (split_cols) { const int t = colt / split_cols; base += (size_t)t * split_stride; colt -= t * split_cols; }
        const int col0 = colt + wc * 32 + 8 * fq, bcol0 = u.pn * BM + wc * 32 + 8 * fq;
        f32x4 bv[2][2];
#pragma unroll
        for (int bj = 0; bj < 2; ++bj)
#pragma unroll
            for (int n = 0; n < 2; ++n) bv[bj][n] = bias ? *(const f32x4*)(bias + bcol0 + bj * HALF + 4 * n) : (f32x4){0.f, 0.f, 0.f, 0.f};
#pragma unroll
        for (int ai = 0; ai < 2; ++ai)
#pragma unroll
            for (int m = 0; m < 4; ++m) { bf16_t* rowp = base + (size_t)(row0 + ai * HALF + m * 16) * ldc + col0;
#pragma unroll
                for (int bj = 0; bj < 2; ++bj) { f32x4 v0 = acc[ai][bj][m][0] + bv[bj][0], v1 = acc[ai][bj][m][1] + bv[bj][1];
                    if (ACT == 1) { f32x2 a = gelu_pk((f32x2){v0[0], v0[1]}), b = gelu_pk((f32x2){v0[2], v0[3]}), c = gelu_pk((f32x2){v1[0], v1[1]}), d = gelu_pk((f32x2){v1[2], v1[3]});
                        v0 = (f32x4){a.x, a.y, b.x, b.y}; v1 = (f32x4){c.x, c.y, d.x, d.y}; }
                    if (ACT == 2) {
#pragma unroll
                        for (int j = 0; j < 4; ++j) { v0[j] = 0.5f * v0[j] * (1.0f + erff(v0[j] * 0.70710678f)); v1[j] = 0.5f * v1[j] * (1.0f + erff(v1[j] * 0.70710678f)); } }
                    u32x4 w; w.x = cvt_pk_bf16(v0[0], v0[1]); w.y = cvt_pk_bf16(v0[2], v0[3]); w.z = cvt_pk_bf16(v1[0], v1[1]); w.w = cvt_pk_bf16(v1[2], v1[3]);
                    *(u32x4*)(rowp + bj * HALF) = w; } }
    }
};
template <class Epi, class Sched, bool STAMP = false, bool ALIGN_EPI = false, bool SP2 = false>
__device__ __forceinline__ void gemm_phase(PG8_LAS unsigned char* lds, const Gemm g, const Sched& S, const Epi& E, unsigned long long* stamps) {
    const int tid = fresh_tid(), wid = __builtin_amdgcn_readfirstlane(tid >> 6), lane = tid & 63, wr = wid >> 2, wc = wid & 3, fr = lane & 15, fq = lane >> 4;
    const int K = g.K, nt = K / BK, LD = g.ld ? g.ld : g.K;
    int ts_lo = 0, ts_hi = 0, nts = 0; const unsigned long long rt_entry = STAMP ? (unsigned long long)wall_clock64() : 0ull;
#define PG8_STAMP() do { if (STAMP && wid == 0 && nts < 64) { const unsigned long long _c = (unsigned long long)clock64(); \
        ts_lo = (lane == nts) ? (int)(unsigned)_c : ts_lo; ts_hi = (lane == nts) ? (int)(unsigned)(_c >> 32) : ts_hi; ++nts; } } while (0)
    PG8_STAMP();
    unsigned voffA[2], voffB[2];
#pragma unroll
    for (int i = 0; i < 2; ++i) { int R, C; stage_rc(tid * 16 + i * 8192, R, C); const int Rb = Epi::PERM ? ((R & ~31) + perm32(R & 31)) : R;
        voffA[i] = (unsigned)(R * LD + C) * 2u; voffB[i] = (unsigned)(Rb * LD + C) * 2u; }
    const size_t kstep = (size_t)(BK * 2);
    const size_t hstep = (size_t)HALF * LD * 2;
    const size_t tstep = 2 * hstep;
    const unsigned ldsw = (unsigned)wid * 1024u;
    const int aoff = lds_byte(wr * 64 + fr, fq * 8), boff = lds_byte(wc * 32 + fr, fq * 8);
#define PG8_SA(b, h) (((b) * 2 + (h)) * HTB)
#define PG8_SB(b, h) ((4 + (b) * 2 + (h)) * HTB)
#define PG8_STAGE(bufoff, gbase, voff) do { _Pragma("unroll") for (int _i = 0; _i < 2; ++_i) \
        __builtin_amdgcn_global_load_lds((const unsigned*)((const char*)(gbase) + (voff)[_i]), (PG8_LAS unsigned*)(lds + (bufoff) + ldsw + _i * 8192), 16, 0, 0); } while (0)
#define PG8_LDA(dst, b, h) do { _Pragma("unroll") for (int m = 0; m < 4; ++m) _Pragma("unroll") for (int k = 0; k < 2; ++k) dst[m][k] = *(const PG8_LAS bf16x8*)(lds + PG8_SA(b, h) + aoff + m * 2048 + k * 1024); } while (0)
#define PG8_LDB(dst, b, h) do { _Pragma("unroll") for (int n = 0; n < 2; ++n) _Pragma("unroll") for (int k = 0; k < 2; ++k) dst[n][k] = *(const PG8_LAS bf16x8*)(lds + PG8_SB(b, h) + boff + n * 2048 + k * 1024); } while (0)
#define PG8_MMA(ai, bj, At, Bt) do { __builtin_amdgcn_s_setprio(1); _Pragma("unroll") for (int m = 0; m < 4; ++m) _Pragma("unroll") for (int n = 0; n < 2; ++n) _Pragma("unroll") for (int k = 0; k < 2; ++k) \
        acc[ai][bj][m][n] = __builtin_amdgcn_mfma_f32_16x16x32_bf16(Bt[n][k], At[m][k], acc[ai][bj][m][n], 0, 0, 0); __builtin_amdgcn_s_setprio(0); } while (0)
#define PG8_WAIT_V(n) asm volatile("s_waitcnt vmcnt(" #n ")" ::: "memory")
#define PG8_WAIT_L(n) asm volatile("s_waitcnt lgkmcnt(" #n ")" ::: "memory")
#define PG8_BAR __builtin_amdgcn_s_barrier()
#define PG8_SCHED __builtin_amdgcn_sched_barrier(0)
    Unit cur, nxt; int ui = 0;
    if (!S.next(0, cur)) return;
    f32x4 acc[2][2][4][2];
#pragma unroll
    for (int a = 0; a < 2; ++a)
#pragma unroll
        for (int b = 0; b < 2; ++b)
#pragma unroll
            for (int m = 0; m < 4; ++m)
#pragma unroll
                for (int n = 0; n < 2; ++n) acc[a][b][m][n] = (f32x4){0.f, 0.f, 0.f, 0.f};
    bf16x8 At[4][2], B0[2][2], B1[2][2];
    const char* cA = (const char*)g.A + (size_t)cur.pm * tstep + (size_t)cur.kh * K * 2; const char* cB = (const char*)g.Bt + (size_t)cur.pn * tstep + (size_t)cur.kh * K * 2;
    S.a_ready(cur);
    if constexpr (SP2) {
        PG8_STAGE(PG8_SB(0, 0), cB, voffB); PG8_STAGE(PG8_SB(0, 1), cB + hstep, voffB); PG8_STAGE(PG8_SA(0, 0), cA, voffA); PG8_STAGE(PG8_SA(0, 1), cA + hstep, voffA);
        if (wr == 1) PG8_BAR;
        PG8_WAIT_V(2); PG8_BAR;
        PG8_STAGE(PG8_SB(1, 0), cB + kstep, voffB); PG8_STAGE(PG8_SA(1, 0), cA + kstep, voffA); PG8_STAGE(PG8_SB(1, 1), cB + hstep + kstep, voffB);
        PG8_WAIT_V(6); PG8_BAR;
    } else {
    PG8_STAGE(PG8_SB(0, 0), cB, voffB); PG8_STAGE(PG8_SA(0, 0), cA, voffA); PG8_STAGE(PG8_SB(0, 1), cB + hstep, voffB); PG8_STAGE(PG8_SA(0, 1), cA + hstep, voffA);
    if (wr == 1) PG8_BAR;
    PG8_WAIT_V(4); PG8_BAR;
    PG8_STAGE(PG8_SB(1, 0), cB + kstep, voffB); PG8_STAGE(PG8_SA(1, 0), cA + kstep, voffA); PG8_STAGE(PG8_SB(1, 1), cB + hstep + kstep, voffB);
    PG8_WAIT_V(6); PG8_BAR;
    }
    PG8_STAMP();
    for (;;) {
        const bool has_next = S.next(ui + 1, nxt);
        const char* nA = has_next ? (const char*)g.A + (size_t)nxt.pm * tstep + (size_t)nxt.kh * K * 2 : cA; const char* nB = has_next ? (const char*)g.Bt + (size_t)nxt.pn * tstep + (size_t)nxt.kh * K * 2 : cB;
        for (int t = 0; t < nt; t += 2) {
            const bool last = (t == nt - 2);
            const char* a1 = cA + (size_t)(t + 1) * kstep;
            const char* a2 = last ? nA : cA + (size_t)(t + 2) * kstep; const char* b2 = last ? nB : cB + (size_t)(t + 2) * kstep;
            const char* a3 = a2 + kstep; const char* b3 = b2 + kstep;
            if (last && has_next) S.a_ready(nxt);
            if constexpr (SP2) {
            PG8_LDB(B0, 0, 0); PG8_LDB(B1, 0, 1); PG8_SCHED; PG8_LDA(At, 0, 0); PG8_STAGE(PG8_SA(1, 1), a1 + hstep, voffA);
            PG8_WAIT_V(8); PG8_WAIT_L(0); PG8_BAR; PG8_MMA(0, 0, At, B0); PG8_MMA(0, 1, At, B1); PG8_BAR; PG8_SCHED;
            PG8_LDA(At, 0, 1); PG8_STAGE(PG8_SB(0, 0), b2, voffB); PG8_STAGE(PG8_SB(0, 1), b2 + hstep, voffB); PG8_STAGE(PG8_SA(0, 0), a2, voffA);
            PG8_WAIT_V(8); PG8_WAIT_L(0); PG8_BAR; PG8_MMA(1, 0, At, B0); PG8_MMA(1, 1, At, B1); PG8_BAR; PG8_SCHED;
            PG8_LDB(B0, 1, 0); PG8_LDB(B1, 1, 1); PG8_SCHED; PG8_LDA(At, 1, 0); PG8_STAGE(PG8_SA(0, 1), a2 + hstep, voffA);
            PG8_WAIT_V(8); PG8_WAIT_L(0); PG8_BAR; PG8_MMA(0, 0, At, B0); PG8_MMA(0, 1, At, B1); PG8_BAR; PG8_SCHED;
            PG8_LDA(At, 1, 1); PG8_STAGE(PG8_SB(1, 0), b3, voffB); PG8_STAGE(PG8_SB(1, 1), b3 + hstep, voffB); PG8_STAGE(PG8_SA(1, 0), a3, voffA);
            PG8_WAIT_V(8); PG8_WAIT_L(0); PG8_BAR; PG8_MMA(1, 0, At, B0); PG8_MMA(1, 1, At, B1); PG8_BAR; PG8_SCHED;
            } else {
            PG8_LDB(B0, 0, 0); PG8_SCHED; PG8_LDA(At, 0, 0); PG8_STAGE(PG8_SA(1, 1), a1 + hstep, voffA);
            PG8_WAIT_L(8); PG8_BAR; PG8_WAIT_L(0); PG8_MMA(0, 0, At, B0); PG8_BAR; PG8_SCHED;
            PG8_LDB(B1, 0, 1); PG8_STAGE(PG8_SB(0, 0), b2, voffB);
            PG8_BAR; PG8_WAIT_L(0); PG8_MMA(0, 1, At, B1); PG8_BAR;
            PG8_LDA(At, 0, 1); PG8_STAGE(PG8_SA(0, 0), a2, voffA);
            PG8_BAR; PG8_WAIT_L(0); PG8_MMA(1, 0, At, B0); PG8_BAR; PG8_SCHED;
            PG8_STAGE(PG8_SB(0, 1), b2 + hstep, voffB);
            PG8_WAIT_V(6); PG8_BAR; PG8_MMA(1, 1, At, B1); PG8_BAR;
            PG8_LDB(B0, 1, 0); PG8_SCHED; PG8_LDA(At, 1, 0); PG8_STAGE(PG8_SA(0, 1), a2 + hstep, voffA);
            PG8_WAIT_L(8); PG8_BAR; PG8_WAIT_L(0); PG8_MMA(0, 0, At, B0); PG8_BAR; PG8_SCHED;
            PG8_LDB(B1, 1, 1); PG8_STAGE(PG8_SB(1, 0), b3, voffB);
            PG8_BAR; PG8_WAIT_L(0); PG8_MMA(0, 1, At, B1); PG8_BAR;
            PG8_LDA(At, 1, 1); PG8_STAGE(PG8_SA(1, 0), a3, voffA);
            PG8_BAR; PG8_WAIT_L(0); PG8_MMA(1, 0, At, B0); PG8_BAR; PG8_SCHED;
            PG8_STAGE(PG8_SB(1, 1), b3 + hstep, voffB);
            PG8_WAIT_V(6); PG8_BAR; PG8_MMA(1, 1, At, B1); PG8_BAR;
            }
        }
        PG8_STAMP();
        if constexpr (ALIGN_EPI) { if (wr == 0) PG8_BAR; }
        if constexpr (Epi::SPLITK) { if (cur.kh == 0) E.mid(acc, cur, wr, wc, fr, fq); else E(acc, cur, wr, wc, fr, fq); }
        else if constexpr (!Epi::AFTER_DRAIN) { E(acc, cur, wr, wc, fr, fq); S.done(cur); }
        PG8_STAMP();
        if (!has_next) break;
        if (!(Epi::SPLITK && cur.kh == 0))
#pragma unroll
        for (int a = 0; a < 2; ++a)
#pragma unroll
            for (int b = 0; b < 2; ++b)
#pragma unroll
                for (int m = 0; m < 4; ++m)
#pragma unroll
                    for (int n = 0; n < 2; ++n) acc[a][b][m][n] = (f32x4){0.f, 0.f, 0.f, 0.f};
        cur = nxt; cA = nA; cB = nB; ++ui;
        if constexpr (ALIGN_EPI) { if (wr == 1) PG8_BAR; }
    }
    PG8_WAIT_V(0);
    if constexpr (!ALIGN_EPI) { if (wr == 0) PG8_BAR; }
    PG8_BAR;
    if constexpr (Epi::AFTER_DRAIN) { E.fused(acc, cur, wr, wc, fr, fq, lds, wid, lane); S.done(cur); }
    PG8_STAMP();
    if (STAMP && wid == 0) { stamps[lane] = lane < nts ? (((unsigned long long)(unsigned)ts_hi << 32) | (unsigned)ts_lo) : 0ull;
        if (lane == 62) stamps[62] = rt_entry; if (lane == 63) stamps[63] = (unsigned long long)wall_clock64(); }
#undef PG8_STAMP
#undef PG8_SA
#undef PG8_SB
#undef PG8_STAGE
#undef PG8_LDA
#undef PG8_LDB
#undef PG8_MMA
#undef PG8_WAIT_V
#undef PG8_WAIT_L
#undef PG8_BAR
#undef PG8_SCHED
}
}

#ifndef DBLC
#define DBLC 0
#endif
#ifndef GEMM_SP2
#define GEMM_SP2 true
#endif
#ifndef GEMM_ALIGN
#define GEMM_ALIGN true
#endif
namespace mk {
#define LAS __attribute__((address_space(3)))
using pg8::bf16_t; using pg8::bf16x8; using pg8::f32x4; using pg8::u32x4;
typedef unsigned u32x2 __attribute__((ext_vector_type(2)));

constexpr int NTOK = 16384, DM = 2048, SEQ = 4096, NIN = 10240, INC = 10256, FF = 5632, NL = 2;
constexpr size_t MiB = (size_t)1 << 20;
constexpr size_t SPL = (size_t)NTOK * 1024;
constexpr size_t WS_WA = 0, WS_WB = 4 * MiB, WS_WOUT = 8 * MiB, WS_WGU = 16 * MiB, WS_WD = 60 * MiB;
constexpr size_t WS_WIN = 82 * MiB;
constexpr size_t WS_ATTN = 82 * MiB, WS_GL = 98 * MiB;
constexpr size_t WS_H = 122 * MiB;
constexpr size_t WS_Y = 122 * MiB;
constexpr size_t WS_O = 186 * MiB;
constexpr size_t WS_PROJ = 186 * MiB;
constexpr size_t WS_MRG = 218 * MiB;
constexpr size_t WS_BETA = 506 * MiB, WS_G = 506 * MiB + 512 * 1024;
constexpr size_t WS_WF = 507 * MiB, WS_QDF = 539 * MiB, WS_KDF = 571 * MiB, WS_UF = 603 * MiB;
constexpr size_t WS_TMP = 507 * MiB;
constexpr size_t WS_H2 = 577 * MiB;
constexpr size_t WS_GU = 82 * MiB;
constexpr size_t WS_HID = 100 * MiB;
constexpr size_t WS_HALO = 507 * MiB, WS_FIXG = 519 * MiB, WS_FIXU = 531 * MiB;
constexpr size_t WS_END = 641 * MiB;
constexpr int LDS_BYTES = 160 * 1024;

struct Params { const float* in[21]; float* out; unsigned char* ws; int ph_lo, ph_hi, dbg, pad; };
typedef const Params __attribute__((address_space(4)))* KP;
__device__ __forceinline__ KP get_kp() { KP k = (KP)__builtin_amdgcn_kernarg_segment_ptr(); asm volatile("" : "+s"(k)); return k; }
__device__ __forceinline__ int launder_i(int v) { asm volatile("" : "+s"(v)); return v; }

__device__ __forceinline__ float bflo(unsigned u) { return __uint_as_float(u << 16); }
__device__ __forceinline__ float bfhi(unsigned u) { return __uint_as_float(u & 0xffff0000u); }
__device__ __forceinline__ float bf2f(bf16_t b) { return __uint_as_float(((unsigned)b) << 16); }
typedef __bf16 bf2_t __attribute__((ext_vector_type(2)));
typedef float f2_t __attribute__((ext_vector_type(2)));
__device__ __forceinline__ unsigned pk(float lo, float hi) { f2_t v = {lo, hi}; bf2_t r = __builtin_convertvector(v, bf2_t); return __builtin_bit_cast(unsigned, r); }
__device__ __forceinline__ float silu_f(float x) { return x * __builtin_amdgcn_rcpf(1.f + __expf(-x)); }
__device__ __forceinline__ float sigm_f(float x) { return __builtin_amdgcn_rcpf(1.f + __expf(-x)); }
__device__ __forceinline__ void gelu2(float a, float b, float& ra, float& rb) { const pg8::f32x2 r = pg8::gelu_pk((pg8::f32x2){a, b}); ra = r.x; rb = r.y; }
__device__ __forceinline__ float wave_sum(float v) {
#pragma unroll
    for (int o = 32; o >= 1; o >>= 1) v += __shfl_xor(v, o);
    return v;
}
__device__ __forceinline__ bf16x8 pack8(const float (&v)[8]) {
    u32x4 w; w.x = pk(v[0], v[1]); w.y = pk(v[2], v[3]); w.z = pk(v[4], v[5]); w.w = pk(v[6], v[7]);
    return __builtin_bit_cast(bf16x8, w);
}
__device__ __forceinline__ bf16x8 pack44(f32x4 a, f32x4 b) {
    u32x4 w; w.x = pk(a[0], a[1]); w.y = pk(a[2], a[3]); w.z = pk(b[0], b[1]); w.w = pk(b[2], b[3]);
    return __builtin_bit_cast(bf16x8, w);
}
#define MFMA(a, b, c) __builtin_amdgcn_mfma_f32_16x16x32_bf16((a), (b), (c), 0, 0, 0)
#define LDS_FENCE() asm volatile("s_waitcnt lgkmcnt(0)" ::: "memory")
#define LDS_BARRIER() do { asm volatile("s_waitcnt lgkmcnt(0)" ::: "memory"); __builtin_amdgcn_s_barrier(); asm volatile("" ::: "memory"); } while (0)

struct EpiRes {
    static constexpr bool PERM = false, AFTER_DRAIN = false, SPLITK = false;
    const float* base; float* out;
    __device__ __forceinline__ void operator()(const f32x4 (&acc)[2][2][4][2], const pg8::Unit& u, int wr, int wc, int fr, int fq) const {
        const int row0 = u.pm * 256 + wr * 64 + fr, col0 = u.pn * 256 + wc * 32 + 4 * fq;
#pragma unroll
        for (int ai = 0; ai < 2; ++ai)
#pragma unroll
            for (int m = 0; m < 4; ++m) { const size_t off = (size_t)(row0 + ai * 128 + m * 16) * DM + col0;
#pragma unroll
                for (int bj = 0; bj < 2; ++bj)
#pragma unroll
                    for (int n = 0; n < 2; ++n) { const f32x4 b = *(const f32x4*)(base + off + bj * 128 + n * 16); *(f32x4*)(out + off + bj * 128 + n * 16) = b + acc[ai][bj][m][n]; }
                asm volatile("" ::: "memory"); }
    }
};
struct EpiMerge {
    static constexpr bool PERM = false, AFTER_DRAIN = false, SPLITK = true;
    const bf16_t* ga; const bf16_t* gb; bf16_t* mrg;
    __device__ __forceinline__ void mid(f32x4 (&acc)[2][2][4][2], const pg8::Unit& u, int wr, int wc, int fr, int fq) const {
        const int row0 = u.pm * 256 + wr * 64 + fr, col0 = u.pn * 256 + wc * 32 + 4 * fq;
        const size_t gofs = (size_t)(col0 >> 10) * SPL + (col0 & 1023);
#pragma unroll
        for (int ai = 0; ai < 2; ++ai)
#pragma unroll
            for (int m = 0; m < 4; ++m) {
                u32x2 va[2][2], vb[2][2];
#pragma unroll
                for (int bj = 0; bj < 2; ++bj)
#pragma unroll
                    for (int n = 0; n < 2; ++n) { const size_t o = gofs + (size_t)(row0 + ai * 128 + m * 16) * 1024 + bj * 128 + n * 16; va[bj][n] = *(const u32x2*)(ga + o); vb[bj][n] = *(const u32x2*)(gb + o); }
#pragma unroll
                for (int bj = 0; bj < 2; ++bj)
#pragma unroll
                    for (int n = 0; n < 2; ++n) {
                        const u32x2 a = va[bj][n], bb = vb[bj][n];
                        f32x4 r;
                        r[0] = (1.f + __expf(-bflo(bb.x))) * __builtin_amdgcn_rcpf(1.f + __expf(-bflo(a.x)));
                        r[1] = (1.f + __expf(-bfhi(bb.x))) * __builtin_amdgcn_rcpf(1.f + __expf(-bfhi(a.x)));
                        r[2] = (1.f + __expf(-bflo(bb.y))) * __builtin_amdgcn_rcpf(1.f + __expf(-bflo(a.y)));
                        r[3] = (1.f + __expf(-bfhi(bb.y))) * __builtin_amdgcn_rcpf(1.f + __expf(-bfhi(a.y)));
                        acc[ai][bj][m][n] *= r;
                    }
                asm volatile("" ::: "memory");
            }
    }
    __device__ __forceinline__ void operator()(const f32x4 (&acc)[2][2][4][2], const pg8::Unit& u, int wr, int wc, int fr, int fq) const {
        const int row0 = u.pm * 256 + wr * 64 + fr, col0 = u.pn * 256 + wc * 32 + 4 * fq;
        const bf16_t* gp = gb + (size_t)(col0 >> 10) * SPL + (col0 & 1023);
#pragma unroll
        for (int ai = 0; ai < 2; ++ai)
#pragma unroll
            for (int m = 0; m < 4; ++m) { const int row = row0 + ai * 128 + m * 16;
#pragma unroll
                for (int bj = 0; bj < 2; ++bj)
#pragma unroll
                    for (int n = 0; n < 2; ++n) { const u32x2 gv = *(const u32x2*)(gp + (size_t)row * 1024 + bj * 128 + n * 16);
                        f32x4 sg; sg[0] = sigm_f(bflo(gv.x)); sg[1] = sigm_f(bfhi(gv.x)); sg[2] = sigm_f(bflo(gv.y)); sg[3] = sigm_f(bfhi(gv.y));
                        const f32x4 r = sg * acc[ai][bj][m][n];
                        u32x2 w; w.x = pk(r[0], r[1]); w.y = pk(r[2], r[3]);
                        *(u32x2*)(mrg + (size_t)row * DM + col0 + bj * 128 + n * 16) = w; }
                asm volatile("" ::: "memory"); }
    }
};
struct PairOrder { pg8::StaticOrder S;
    __device__ __forceinline__ bool next(int i, pg8::Unit& u) const { if (!S.next(i >> 1, u)) return false; u.kh = i & 1; return true; }
    __device__ __forceinline__ void a_ready(const pg8::Unit&) const {}
    __device__ __forceinline__ void done(const pg8::Unit&) const {}
};
struct OneUnit { pg8::Unit u;
    __device__ __forceinline__ bool next(int i, pg8::Unit& o) const { if (i != 0) return false; o = u; return true; }
    __device__ __forceinline__ void a_ready(const pg8::Unit&) const {}
    __device__ __forceinline__ void done(const pg8::Unit&) const {}
};
__device__ __forceinline__ float dpp_ror1(float v) { return __builtin_bit_cast(float, __builtin_amdgcn_update_dpp(0, __builtin_bit_cast(int, v), 0x121, 0xF, 0xF, false)); }
__device__ __forceinline__ float dpp_ror2(float v) { return __builtin_bit_cast(float, __builtin_amdgcn_update_dpp(0, __builtin_bit_cast(int, v), 0x122, 0xF, 0xF, false)); }
struct EpiFfn {
    static constexpr bool PERM = false, AFTER_DRAIN = false, SPLITK = false;
    bf16_t* hid; const float* cw; const float* cb; float* halo; float* fixg; float* fixu;
    __device__ __forceinline__ void operator()(const f32x4 (&acc)[2][2][4][2], const pg8::Unit& u, int wr, int wc, int fr, int fq) const {
        const int ch0 = u.pn * 128 + wc * 32 + 4 * fq;
#pragma unroll
        for (int n = 0; n < 2; ++n) {
            const f32x4 w0 = *(const f32x4*)(cw + ch0 + 16 * n), w1 = *(const f32x4*)(cw + FF + ch0 + 16 * n), w2 = *(const f32x4*)(cw + 2 * FF + ch0 + 16 * n), bb = *(const f32x4*)(cb + ch0 + 16 * n);
#pragma unroll
            for (int ai = 0; ai < 2; ++ai) {
                const int grp = u.pm * 4 + ai * 2 + wr;
#pragma unroll
                for (int m = 0; m < 4; ++m) {
                    const f32x4 g0 = acc[ai][0][m][n], up = acc[ai][1][m][n];
                    f32x4 g1, g2;
#pragma unroll
                    for (int c = 0; c < 4; ++c) {
                        const float t1 = dpp_ror1(g0[c]), t2 = dpp_ror2(g0[c]);
                        if (m > 0) { const float p1 = dpp_ror1(acc[ai][0][m > 0 ? m - 1 : 0][n][c]), p2 = dpp_ror2(acc[ai][0][m > 0 ? m - 1 : 0][n][c]); g1[c] = (fr == 0) ? p1 : t1; g2[c] = (fr < 2) ? p2 : t2; }
                        else { g1[c] = t1; g2[c] = t2; }
                    }
                    const int row = grp * 64 + m * 16 + fr;
                    if (m > 0 || fr >= 2) {
                        const f32x4 gt = w0 * g2 + w1 * g1 + w2 * g0 + bb;
                        u32x2 w; w.x = pk(silu_f(gt[0]) * up[0], silu_f(gt[1]) * up[1]); w.y = pk(silu_f(gt[2]) * up[2], silu_f(gt[3]) * up[3]);
                        *(u32x2*)(hid + (size_t)row * FF + ch0 + 16 * n) = w;
                    } else {
                        *(f32x4*)(fixg + (size_t)(grp * 2 + fr) * FF + ch0 + 16 * n) = g0;
                        *(f32x4*)(fixu + (size_t)(grp * 2 + fr) * FF + ch0 + 16 * n) = up;
                    }
                    if (m == 3 && fr >= 14) *(f32x4*)(halo + (size_t)(grp * 2 + fr - 14) * FF + ch0 + 16 * n) = g0;
                }
                asm volatile("" ::: "memory");
            }
        }
    }
};
__device__ __forceinline__ void ffn_fix_phase(KP p, int l) {
    const float* halo = (const float*)(p->ws + WS_HALO); const float* fixg = (const float*)(p->ws + WS_FIXG); const float* fixu = (const float*)(p->ws + WS_FIXU);
    bf16_t* hid = (bf16_t*)(p->ws + WS_HID);
    const float* cw = p->in[17] + (size_t)l * 3 * FF; const float* cb = p->in[18] + (size_t)l * FF;
    const int nitem = 256 * 2 * (FF / 4);
    for (int it = blockIdx.x * 512 + fresh_tid(); it < nitem; it += gridDim.x * 512) {
        const int c4 = it % (FF / 4), pr = it / (FF / 4), row = pr & 1, grp = pr >> 1, ch = 4 * c4;
        const bool hist = (grp & 63) != 0;
        const f32x4 z = {0.f, 0.f, 0.f, 0.f};
        const f32x4 g0 = *(const f32x4*)(fixg + (size_t)(grp * 2 + row) * FF + ch), up = *(const f32x4*)(fixu + (size_t)(grp * 2 + row) * FF + ch);
        f32x4 g1, g2;
        if (row == 0) { g1 = hist ? *(const f32x4*)(halo + (size_t)((grp - 1) * 2 + 1) * FF + ch) : z; g2 = hist ? *(const f32x4*)(halo + (size_t)((grp - 1) * 2 + 0) * FF + ch) : z; }
        else { g1 = *(const f32x4*)(fixg + (size_t)(grp * 2 + 0) * FF + ch); g2 = hist ? *(const f32x4*)(halo + (size_t)((grp - 1) * 2 + 1) * FF + ch) : z; }
        const f32x4 w0 = *(const f32x4*)(cw + ch), w1 = *(const f32x4*)(cw + FF + ch), w2 = *(const f32x4*)(cw + 2 * FF + ch), bb = *(const f32x4*)(cb + ch);
        const f32x4 gt = w0 * g2 + w1 * g1 + w2 * g0 + bb;
        u32x2 w; w.x = pk(silu_f(gt[0]) * up[0], silu_f(gt[1]) * up[1]); w.y = pk(silu_f(gt[2]) * up[2], silu_f(gt[3]) * up[3]);
        *(u32x2*)(hid + (size_t)(grp * 64 + row) * FF + ch) = w;
    }
}

__device__ __forceinline__ void xpose_phase(KP p, int l, LAS float* tile) {
    const int tid = fresh_tid(), G = gridDim.x;
    unsigned char* ws = p->ws;
    constexpr int T_IN = 32 * 40, T_A = 16 * 8, T_OUT = 32 * 8, T_GU = 32 * 44, T_D = 88 * 8, T_ALL = T_IN + 2 * T_A + T_OUT + T_GU + T_D;
    for (int t = blockIdx.x; t < T_ALL; t += G) {
        int u = t; const float* src; int ld, K, nct; bf16_t* dst; int kind; int ldk = 0;
        if (u < T_IN) { kind = 0; src = p->in[2] + (size_t)l * DM * INC; ld = INC; K = DM; nct = 40; dst = (bf16_t*)(ws + WS_WIN); }
        else if ((u -= T_IN) < T_A) { kind = 1; src = p->in[11] + (size_t)l * 1024 * DM; ld = DM; K = 1024; nct = 8; dst = (bf16_t*)(ws + WS_WA); ldk = 2048; }
        else if ((u -= T_A) < T_A) { kind = 1; src = p->in[12] + (size_t)l * 1024 * DM; ld = DM; K = 1024; nct = 8; dst = (bf16_t*)(ws + WS_WA) + 1024; ldk = 2048; }
        else if ((u -= T_A) < T_OUT) { kind = 1; src = p->in[13] + (size_t)l * DM * DM; ld = DM; K = DM; nct = 8; dst = (bf16_t*)(ws + WS_WOUT); }
        else if ((u -= T_OUT) < T_GU) { kind = 2; src = p->in[15] + (size_t)l * DM * FF; ld = FF; K = DM; nct = 44; dst = (bf16_t*)(ws + WS_WGU); }
        else { u -= T_GU; kind = 1; src = p->in[19] + (size_t)l * FF * DM; ld = DM; K = FF; nct = 8; dst = (bf16_t*)(ws + WS_WD); }
        const int kb = u / nct, nb = u - kb * nct, k0 = kb * 64, n0 = nb * 256;
        int sc = n0;
        if (kind == 0) sc = n0 + (n0 >= 4096 ? 16 : 0);
        {
            const int r = tid >> 6, c4 = tid & 63;
            f32x4 v[8];
            const float* srcp = src + sc + 4 * c4;
            if (kind == 2) srcp = (c4 < 32) ? src + 128 * nb + 4 * c4 : p->in[16] + (size_t)l * DM * FF + 128 * nb + 4 * (c4 - 32);
#pragma unroll
            for (int i = 0; i < 8; ++i) v[i] = __builtin_nontemporal_load((const f32x4*)(srcp + (size_t)(k0 + r + 8 * i) * ld));
#pragma unroll
            for (int i = 0; i < 8; ++i) *(LAS f32x4*)(tile + (r + 8 * i) * 260 + 4 * c4) = v[i];
        }
        __syncthreads();
#pragma unroll
        for (int j = 0; j < 4; ++j) {
            const int q = tid + 512 * j, n = q >> 3, kc = q & 7;
            float v[8];
#pragma unroll
            for (int e = 0; e < 8; ++e) v[e] = tile[(kc * 8 + e) * 260 + n];
            u32x4 w; w.x = pk(v[0], v[1]); w.y = pk(v[2], v[3]); w.z = pk(v[4], v[5]); w.w = pk(v[6], v[7]);
            *(u32x4*)(dst + (size_t)(n0 + n) * (ldk ? ldk : K) + k0 + kc * 8) = w;
        }
        __syncthreads();
    }
}

__device__ __forceinline__ void norm1_phase(KP p, int l, LAS float* wT) {
    const int tid = fresh_tid(), lane = tid & 63, wave = tid >> 6, G = gridDim.x;
    const float* x = (l == 0) ? p->in[0] : p->out;
    const float* gn = p->in[1] + (size_t)l * DM;
    const float* wsl = p->in[2] + (size_t)l * DM * INC + 4096;
    bf16_t* h = (bf16_t*)(p->ws + WS_H);
    float* beta = (float*)(p->ws + WS_BETA); float* gg = (float*)(p->ws + WS_G);
    for (int idx = tid; idx < DM * 4; idx += 512) {
        const int k = idx >> 2, j4 = idx & 3;
        const float4 v = *(const float4*)(wsl + (size_t)k * INC + 4 * j4);
        wT[(4 * j4 + 0) * DM + k] = v.x; wT[(4 * j4 + 1) * DM + k] = v.y; wT[(4 * j4 + 2) * DM + k] = v.z; wT[(4 * j4 + 3) * DM + k] = v.w;
    }
    __syncthreads();
    const float alog = (((lane >> 2) & 15) >= 8) ? p->in[4][l * 8 + ((lane >> 2) & 15) - 8] : 0.f;
    const float dtb = (((lane >> 2) & 15) >= 8) ? p->in[5][l * 8 + ((lane >> 2) & 15) - 8] : 0.f;
    for (int row = blockIdx.x * 8 + wave; row < NTOK; row += G * 8) {
        float4 xv[8]; float ss = 0.f;
#pragma unroll
        for (int i = 0; i < 8; ++i) { xv[i] = *(const float4*)(x + (size_t)row * DM + 4 * (lane + 64 * i)); ss += xv[i].x * xv[i].x + xv[i].y * xv[i].y + xv[i].z * xv[i].z + xv[i].w * xv[i].w; }
        ss = wave_sum(ss);
        const float rstd = rsqrtf(ss * (1.f / DM) + 1e-6f);
#pragma unroll
        for (int i = 0; i < 8; ++i) { const float4 gv = *(const float4*)(gn + 4 * (lane + 64 * i));
            xv[i].x *= rstd * gv.x; xv[i].y *= rstd * gv.y; xv[i].z *= rstd * gv.z; xv[i].w *= rstd * gv.w;
            u32x2 w; w.x = pk(xv[i].x, xv[i].y); w.y = pk(xv[i].z, xv[i].w);
            *(u32x2*)(h + (size_t)row * DM + 4 * (lane + 64 * i)) = w; }
        float a16[16];
#pragma unroll
        for (int j = 0; j < 16; ++j) {
            float a = 0.f;
#pragma unroll
            for (int i = 0; i < 8; ++i) { const f32x4 w = *(const LAS f32x4*)(wT + j * DM + 4 * (lane + 64 * i)); a += xv[i].x * w[0] + xv[i].y * w[1] + xv[i].z * w[2] + xv[i].w * w[3]; }
            a16[j] = a;
            if ((j & 3) == 3) asm volatile("" ::: "memory");
        }
        float b8[8], c4[4], d2[2];
        { const bool up = (lane & 32) != 0;
#pragma unroll
          for (int i = 0; i < 8; ++i) { const float snd = up ? a16[i] : a16[i + 8], keep = up ? a16[i + 8] : a16[i]; b8[i] = keep + __shfl_xor(snd, 32); } }
        { const bool up = (lane & 16) != 0;
#pragma unroll
          for (int i = 0; i < 4; ++i) { const float snd = up ? b8[i] : b8[i + 4], keep = up ? b8[i + 4] : b8[i]; c4[i] = keep + __shfl_xor(snd, 16); } }
        { const bool up = (lane & 8) != 0;
#pragma unroll
          for (int i = 0; i < 2; ++i) { const float snd = up ? c4[i] : c4[i + 2], keep = up ? c4[i + 2] : c4[i]; d2[i] = keep + __shfl_xor(snd, 8); } }
        float mine;
        { const bool up = (lane & 4) != 0; const float snd = up ? d2[0] : d2[1], keep = up ? d2[1] : d2[0]; mine = keep + __shfl_xor(snd, 4); }
        mine += __shfl_xor(mine, 2); mine += __shfl_xor(mine, 1);
        const int jj = (lane >> 2) & 15;
        if ((lane & 3) == 0) {
            if (jj < 8) beta[(size_t)row * 8 + jj] = sigm_f(mine);
            else { const float z = mine + dtb; const float sp = fmaxf(z, 0.f) + log1pf(__expf(-fabsf(z))); gg[(size_t)row * 8 + jj - 8] = -__expf(alog) * sp; }
        }
    }
}
template <bool F32OUT>
__device__ __forceinline__ void norm_phase(const float* x, const float* gn, bf16_t* hb, float* of) {
    const int tid = fresh_tid(), lane = tid & 63, wave = tid >> 6, G = gridDim.x;
    for (int row = blockIdx.x * 8 + wave; row < NTOK; row += G * 8) {
        float4 xv[8]; float ss = 0.f;
#pragma unroll
        for (int i = 0; i < 8; ++i) { xv[i] = *(const float4*)(x + (size_t)row * DM + 4 * (lane + 64 * i)); ss += xv[i].x * xv[i].x + xv[i].y * xv[i].y + xv[i].z * xv[i].z + xv[i].w * xv[i].w; }
        ss = wave_sum(ss);
        const float rstd = rsqrtf(ss * (1.f / DM) + 1e-6f);
#pragma unroll
        for (int i = 0; i < 8; ++i) { const float4 gv = *(const float4*)(gn + 4 * (lane + 64 * i));
            xv[i].x *= rstd * gv.x; xv[i].y *= rstd * gv.y; xv[i].z *= rstd * gv.z; xv[i].w *= rstd * gv.w;
            if (F32OUT) *(float4*)(of + (size_t)row * DM + 4 * (lane + 64 * i)) = xv[i];
            else { u32x2 w; w.x = pk(xv[i].x, xv[i].y); w.y = pk(xv[i].z, xv[i].w); *(u32x2*)(hb + (size_t)row * DM + 4 * (lane + 64 * i)) = w; } }
    }
}

__device__ __forceinline__ void gmlp_phase(KP p, int l, LAS unsigned char* lds) {
    const int tid = fresh_tid(), lane = tid & 63, wave = tid >> 6, fr = lane & 15, fq = lane >> 4, G = gridDim.x;
    LAS bf16_t* vgT = (LAS bf16_t*)lds;
    LAS float* st = (LAS float*)(lds + 128 * 136 * 2);
    const bf16_t* Tu = (const bf16_t*)(p->ws + WS_PROJ) + 4 * SPL;
    const bf16_t* Tv = (const bf16_t*)(p->ws + WS_PROJ) + 5 * SPL;
    bf16_t* yb = (bf16_t*)(p->ws + WS_Y) + 1024;
    const float* lng = p->in[7] + (size_t)l * 1024; const float* lnb = p->in[8] + (size_t)l * 1024;
    const float* sgw = p->in[9] + (size_t)l * 8 * 128 * 128; const float* sgb = p->in[10] + (size_t)l * 8 * 128;
    for (int it = blockIdx.x; it < 256; it += G) {
        const int tok0 = ((it & 7) + 8 * (it >> 4)) * 128, g0 = ((it >> 3) & 1) * 4;
        for (int t4 = 0; t4 < 4; ++t4) {
            u32x4 ra[4], rb[4];
#pragma unroll
            for (int q = 0; q < 4; ++q) { const bf16_t* rp = Tv + (size_t)(tok0 + wave * 16 + t4 * 4 + q) * 1024 + lane * 16; ra[q] = *(const u32x4*)rp; rb[q] = *(const u32x4*)(rp + 8); }
            float sv[4], qv[4];
#pragma unroll
            for (int q = 0; q < 4; ++q) {
                const unsigned wv[8] = {ra[q].x, ra[q].y, ra[q].z, ra[q].w, rb[q].x, rb[q].y, rb[q].z, rb[q].w};
                float s = 0.f, qq = 0.f;
#pragma unroll
                for (int e = 0; e < 8; ++e) { float g0_, g1_; gelu2(bflo(wv[e]), bfhi(wv[e]), g0_, g1_); s += g0_ + g1_; qq += g0_ * g0_ + g1_ * g1_; }
                sv[q] = s; qv[q] = qq;
            }
#pragma unroll
            for (int o = 32; o >= 1; o >>= 1) {
#pragma unroll
                for (int q = 0; q < 4; ++q) { sv[q] += __shfl_xor(sv[q], o); qv[q] += __shfl_xor(qv[q], o); }
            }
            if (lane < 4) {
                const float s = (lane == 0) ? sv[0] : (lane == 1) ? sv[1] : (lane == 2) ? sv[2] : sv[3];
                const float qq = (lane == 0) ? qv[0] : (lane == 1) ? qv[1] : (lane == 2) ? qv[2] : qv[3];
                const float mean = s * (1.f / 1024.f), var = fmaxf(qq * (1.f / 1024.f) - mean * mean, 0.f);
                const int tk = wave * 16 + t4 * 4 + lane;
                st[2 * tk] = mean; st[2 * tk + 1] = rsqrtf(var + 1e-6f);
            }
        }
        const int bj = tid >> 2, bcb = (tid & 3) * 32;
        const int mi = wave * 16 + fr;
        const int nkk = (wave * 16 + 15) / 32 + 1;
        u32x4 tvr[4]; f32x4 lg[8], lb[8]; f32x4 swr[8]; u32x2 uvr[8]; float bi;
#define GM_LOAD_A(g) do { const bf16_t* rp = Tv + (size_t)(tok0 + bj) * 1024 + (g) * 128 + bcb; \
            _Pragma("unroll") for (int q4 = 0; q4 < 4; ++q4) tvr[q4] = *(const u32x4*)(rp + q4 * 8); \
            _Pragma("unroll") for (int q8 = 0; q8 < 8; ++q8) { lg[q8] = *(const f32x4*)(lng + (g) * 128 + bcb + 4 * q8); lb[q8] = *(const f32x4*)(lnb + (g) * 128 + bcb + 4 * q8); } } while (0)
#define GM_LOAD_B(g) do { _Pragma("unroll") for (int kk = 0; kk < 4; ++kk) { const float* wp = sgw + ((size_t)(g) * 128 + mi) * 128 + 32 * kk + 8 * fq; swr[2 * kk] = *(const f32x4*)wp; swr[2 * kk + 1] = *(const f32x4*)(wp + 4); } \
            _Pragma("unroll") for (int mt = 0; mt < 8; ++mt) uvr[mt] = *(const u32x2*)(Tu + (size_t)(tok0 + mi) * 1024 + (g) * 128 + 16 * mt + 4 * fq); \
            bi = sgb[(g) * 128 + mi]; } while (0)
        GM_LOAD_A(g0); GM_LOAD_B(g0);
        LDS_BARRIER();
#pragma unroll 1
        for (int g = g0; g < g0 + 4; ++g) {
            {
                const float mean = st[2 * bj], rstd = st[2 * bj + 1];
#pragma unroll
                for (int q4 = 0; q4 < 4; ++q4) {
                    const unsigned wv[4] = {tvr[q4].x, tvr[q4].y, tvr[q4].z, tvr[q4].w};
#pragma unroll
                    for (int e = 0; e < 4; ++e) {
                        const int cl = q4 * 8 + 2 * e, c = bcb + cl;
                        float ge0, ge1; gelu2(bflo(wv[e]), bfhi(wv[e]), ge0, ge1);
                        const float v0 = (ge0 - mean) * rstd * lg[cl >> 2][cl & 3] + lb[cl >> 2][cl & 3];
                        const float v1 = (ge1 - mean) * rstd * lg[(cl + 1) >> 2][(cl + 1) & 3] + lb[(cl + 1) >> 2][(cl + 1) & 3];
                        const unsigned pw = pk(v0, v1);
                        vgT[c * 136 + bj] = (bf16_t)(pw & 0xffffu); vgT[(c + 1) * 136 + bj] = (bf16_t)(pw >> 16);
                    }
                }
            }
            if (g + 1 < g0 + 4) GM_LOAD_A(g + 1);
            LDS_BARRIER();
            {
                bf16x8 yf[4];
#pragma unroll
                for (int kk = 0; kk < 4; ++kk) {
                    float v[8];
                    const f32x4 a = swr[2 * kk], b2 = swr[2 * kk + 1];
                    v[0] = a[0]; v[1] = a[1]; v[2] = a[2]; v[3] = a[3]; v[4] = b2[0]; v[5] = b2[1]; v[6] = b2[2]; v[7] = b2[3];
#pragma unroll
                    for (int e = 0; e < 8; ++e) v[e] = (32 * kk + 8 * fq + e <= mi) ? v[e] : 0.f;
                    yf[kk] = pack8(v);
                }
#pragma unroll
                for (int mt = 0; mt < 8; ++mt) {
                    f32x4 d = {0.f, 0.f, 0.f, 0.f};
#pragma unroll
                    for (int kk = 0; kk < 4; ++kk) if (kk < nkk) {
                        const bf16x8 xf = *(const LAS bf16x8*)(vgT + (16 * mt + fr) * 136 + 32 * kk + 8 * fq);
                        d = MFMA(xf, yf[kk], d);
                    }
                    const size_t offy = (size_t)(tok0 + mi) * 2048 + g * 128 + 16 * mt + 4 * fq;
                    const u32x2 uv = uvr[mt];
                    float u0, u1, u2, u3; gelu2(bflo(uv.x), bfhi(uv.x), u0, u1); gelu2(bflo(uv.y), bfhi(uv.y), u2, u3);
                    const float r0 = u0 * (d[0] + bi), r1 = u1 * (d[1] + bi), r2 = u2 * (d[2] + bi), r3 = u3 * (d[3] + bi);
                    u32x2 w; w.x = pk(r0, r1); w.y = pk(r2, r3);
                    *(u32x2*)(yb + offy) = w;
                }
            }
            if (g + 1 < g0 + 4) GM_LOAD_B(g + 1);
            LDS_BARRIER();
        }
#undef GM_LOAD_A
#undef GM_LOAD_B
    }
}

__device__ __forceinline__ void conv32L(const bf16_t* xrow, int s, const LAS float* wl, float (&o)[4][8]) {
#pragma unroll
    for (int kk = 0; kk < 4; ++kk)
#pragma unroll
        for (int e = 0; e < 8; ++e) o[kk][e] = 0.f;
#pragma unroll
    for (int rh = 0; rh < 2; ++rh) {
        u32x2 x[2][4][2];
#pragma unroll
        for (int r2 = 0; r2 < 2; ++r2) {
            const int r = 2 * rh + r2;
            const bool ok = (s - r >= 0);
#pragma unroll
            for (int kk = 0; kk < 4; ++kk) {
                const u32x2 a = *(const u32x2*)(xrow - r * 1024 + 32 * kk), bb = *(const u32x2*)(xrow - r * 1024 + 32 * kk + 16);
                x[r2][kk][0] = ok ? a : (u32x2){0u, 0u}; x[r2][kk][1] = ok ? bb : (u32x2){0u, 0u};
            }
        }
#pragma unroll
        for (int kk = 0; kk < 4; ++kk) {
#pragma unroll
            for (int r2 = 0; r2 < 2; ++r2) {
                const int r = 2 * rh + r2;
                const f32x4 w0 = *(const LAS f32x4*)(wl + (3 - r) * 128 + 32 * kk), w1 = *(const LAS f32x4*)(wl + (3 - r) * 128 + 32 * kk + 16);
                const u32x2 x0 = x[r2][kk][0], x1 = x[r2][kk][1];
                o[kk][0] += w0[0] * bflo(x0.x); o[kk][1] += w0[1] * bfhi(x0.x); o[kk][2] += w0[2] * bflo(x0.y); o[kk][3] += w0[3] * bfhi(x0.y);
                o[kk][4] += w1[0] * bflo(x1.x); o[kk][5] += w1[1] * bfhi(x1.x); o[kk][6] += w1[2] * bflo(x1.y); o[kk][7] += w1[3] * bfhi(x1.y);
            }
        }
        asm volatile("" ::: "memory");
    }
#pragma unroll
    for (int kk = 0; kk < 4; ++kk)
#pragma unroll
        for (int e = 0; e < 8; ++e) o[kk][e] = silu_f(o[kk][e]);
}
__device__ __forceinline__ void stage67(const bf16_t* T, int tok0, int s0, int col0, LAS unsigned char* st, int lane) {
    const int rg = lane >> 3, pc = lane & 7;
    u32x4 v[9];
#pragma unroll
    for (int it = 0; it < 9; ++it) {
        const int jr = it * 8 + rg;
        v[it] = (u32x4){0u, 0u, 0u, 0u};
        if (jr < 67 && s0 - 3 + jr >= 0) v[it] = *(const u32x4*)(T + (ptrdiff_t)(tok0 - 3 + jr) * 1024 + col0 + 8 * pc);
    }
#pragma unroll
    for (int it = 0; it < 9; ++it) { const int jr = it * 8 + rg; if (jr < 67) *(LAS u32x4*)(st + jr * 144 + pc * 16) = v[it]; }
}

__device__ __forceinline__ void dn_chunk(KP p, int l, int b, int n, int h, LAS float* Tm  , LAS float* sc  , LAS float* wq  ) {
    const int lane = fresh_tid() & 63, fr = lane & 15, fq = lane >> 4;
    unsigned char* ws = p->ws;
    const bf16_t* Tq = (const bf16_t*)(ws + WS_PROJ);
    const bf16_t* Tk = Tq + SPL; const bf16_t* Tv = Tq + 2 * SPL;
    const float* cw = p->in[3] + (size_t)l * 4 * 3072;
    const int tok0 = b * SEQ + 64 * n, s0 = 64 * n, cid = (b * 8 + h) * 64 + n;
    u32x4* wf = (u32x4*)(ws + WS_WF) + (size_t)cid * 1024;
    u32x4* qdf = (u32x4*)(ws + WS_QDF) + (size_t)cid * 1024;
    u32x4* kdf = (u32x4*)(ws + WS_KDF) + (size_t)cid * 1024;
    u32x4* atf = (u32x4*)(ws + WS_ATTN) + (size_t)cid * 512;
    u32x2* uf = (u32x2*)(ws + WS_UF) + (size_t)cid * 2048;
    LAS float* sgc = sc; LAS float* sbt = sc + 64; LAS float* seg = sc + 128; LAS float* srk = sc + 192;
    LAS float* wk = Tm;

    float gl;
    {
        float gcs = ((const float*)(ws + WS_G))[(size_t)(tok0 + lane) * 8 + h];
        const float bj_own = ((const float*)(ws + WS_BETA))[(size_t)(tok0 + lane) * 8 + h];
        float wqv[8], wkv[8];
#pragma unroll
        for (int i = 0; i < 8; ++i) { const int idx = lane + 64 * i; wqv[i] = cw[(idx >> 7) * 3072 + h * 128 + (idx & 127)]; wkv[i] = cw[(idx >> 7) * 3072 + 1024 + h * 128 + (idx & 127)]; }
#pragma unroll
        for (int o = 1; o < 64; o <<= 1) { const float t = __shfl_up(gcs, o); if (lane >= o) gcs += t; }
        gl = __shfl(gcs, 63);
        sgc[lane] = gcs; sbt[lane] = bj_own; seg[lane] = __expf(gcs);
        if (lane == 0) ((float*)(ws + WS_GL))[cid] = gl;
#pragma unroll
        for (int i = 0; i < 8; ++i) { wq[lane + 64 * i] = wqv[i]; wk[lane + 64 * i] = wkv[i]; }
    }
    LDS_FENCE();

    u32x4* ktmp = kdf;
#pragma unroll 1
    for (int mt = 0; mt < (((DBLC) & 1) ? 8 : 4); ++mt) {
        const int j = 16 * (mt & 3) + fr;
        float kv[4][8]; float ss = 0.f;
        conv32L(Tk + (size_t)(tok0 + j) * 1024 + h * 128 + 4 * fq, s0 + j, wk + 4 * fq, kv);
#pragma unroll
        for (int kk = 0; kk < 4; ++kk)
#pragma unroll
            for (int e = 0; e < 8; ++e) ss += kv[kk][e] * kv[kk][e];
        ss += __shfl_xor(ss, 16); ss += __shfl_xor(ss, 32);
        const float rn = rsqrtf(ss + 1e-6f);
        if (fq == 0) srk[j] = rn;
#pragma unroll
        for (int kk = 0; kk < 4; ++kk) {
#pragma unroll
            for (int e = 0; e < 8; ++e) kv[kk][e] *= rn;
            ktmp[((mt & 3) * 4 + kk) * 64 + lane] = __builtin_bit_cast(u32x4, pack8(kv[kk]));
        }
    }
    asm volatile("s_waitcnt vmcnt(0) lgkmcnt(0)" ::: "memory");
    for (int r = 0; r < 64; ++r) Tm[r * 68 + lane] = 0.f;
    LDS_FENCE();
#pragma unroll 1
    for (int mt2 = 0; mt2 < (((DBLC) & 2) ? 8 : 4); ++mt2) {
        const int mt = mt2 & 3;
        const int i = 16 * mt + fr;
        bf16x8 qf[4], kfm[4];
        {
            float qv[4][8]; float ss = 0.f;
            conv32L(Tq + (size_t)(tok0 + i) * 1024 + h * 128 + 4 * fq, s0 + i, wq + 4 * fq, qv);
#pragma unroll
            for (int kk = 0; kk < 4; ++kk)
#pragma unroll
                for (int e = 0; e < 8; ++e) ss += qv[kk][e] * qv[kk][e];
            ss += __shfl_xor(ss, 16); ss += __shfl_xor(ss, 32);
            const float rn = rsqrtf(ss + 1e-6f) * 0.08838834764831845f;
            const float egi = seg[i];
#pragma unroll
            for (int kk = 0; kk < 4; ++kk) {
                float qd[8];
#pragma unroll
                for (int e = 0; e < 8; ++e) { qv[kk][e] *= rn; qd[e] = qv[kk][e] * egi; }
                qf[kk] = pack8(qv[kk]);
                qdf[(mt * 4 + kk) * 64 + lane] = __builtin_bit_cast(u32x4, pack8(qd));
                kfm[kk] = __builtin_bit_cast(bf16x8, ktmp[(mt * 4 + kk) * 64 + lane]);
            }
        }
        const float gci = sgc[i], bi = sbt[i];
#pragma unroll 1
        for (int k2 = 0; k2 < 2; ++k2) {
            f32x4 at[2];
#pragma unroll
            for (int hf = 0; hf < 2; ++hf) {
                const int nt = 2 * k2 + hf;
                at[hf] = (f32x4){0.f, 0.f, 0.f, 0.f};
                if (nt <= mt) {
                    f32x4 dq = {0.f, 0.f, 0.f, 0.f}, dk = {0.f, 0.f, 0.f, 0.f};
#pragma unroll
                    for (int kk = 0; kk < 4; ++kk) { const bf16x8 kfn = __builtin_bit_cast(bf16x8, ktmp[(nt * 4 + kk) * 64 + lane]); dq = MFMA(kfn, qf[kk], dq); dk = MFMA(kfn, kfm[kk], dk); }
                    const f32x4 gcj = *(const LAS f32x4*)(sgc + 16 * nt + 4 * fq);
                    f32x4 lv;
#pragma unroll
                    for (int jj = 0; jj < 4; ++jj) {
                        const int j = 16 * nt + 4 * fq + jj;
                        const float dec = (j <= i) ? __expf(gci - gcj[jj]) : 0.f;
                        at[hf][jj] = dq[jj] * dec;
                        lv[jj] = (j < i) ? bi * dk[jj] * dec : 0.f;
                    }
                    *(LAS f32x4*)(Tm + i * 68 + 16 * nt + 4 * fq) = lv;
                }
            }
            atf[(mt * 2 + k2) * 64 + lane] = __builtin_bit_cast(u32x4, pack44(at[0], at[1]));
            asm volatile("" ::: "memory");
        }
    }
    asm volatile("s_waitcnt vmcnt(0) lgkmcnt(0)" ::: "memory");
#pragma unroll 1
    for (int i = 0; i < 64; ++i) {
        float acc = (lane == i) ? 1.f : 0.f;
#pragma unroll
        for (int jb = 0; jb < 64; jb += 16) {
            if (jb < i) {
                f32x4 lv[4]; float t[16];
#pragma unroll
                for (int q4 = 0; q4 < 4; ++q4) lv[q4] = *(const LAS f32x4*)(Tm + i * 68 + jb + 4 * q4);
#pragma unroll
                for (int e = 0; e < 16; ++e) t[e] = Tm[(jb + e) * 68 + lane];
#pragma unroll
                for (int e = 0; e < 16; ++e) acc -= lv[e >> 2][e & 3] * t[e];
            }
        }
        LDS_FENCE();
        Tm[i * 68 + lane] = (lane <= i) ? acc : 0.f;
        LDS_FENCE();
    }
    bf16x8 Tf[4][2];
#pragma unroll
    for (int mt = 0; mt < 4; ++mt)
#pragma unroll
        for (int k2 = 0; k2 < 2; ++k2) {
            const f32x4 a = *(const LAS f32x4*)(Tm + (16 * mt + fr) * 68 + 32 * k2 + 4 * fq), bb = *(const LAS f32x4*)(Tm + (16 * mt + fr) * 68 + 32 * k2 + 16 + 4 * fq);
            Tf[mt][k2] = pack44(a, bb);
        }
    LDS_FENCE();
    LAS unsigned char* st = (LAS unsigned char*)Tm;
#pragma unroll 1
    for (int pass2 = 0; pass2 < (((DBLC) & 4) ? 8 : 4); ++pass2) {
        const int pass = pass2 & 3;
        const int isv = pass >> 1, hh = pass & 1;
        if (hh == 0) {
            float wv8[8];
#pragma unroll
            for (int i = 0; i < 8; ++i) { const int idx = lane + 64 * i; wv8[i] = cw[(idx >> 7) * 3072 + 1024 + 1024 * isv + h * 128 + (idx & 127)]; }
#pragma unroll
            for (int i = 0; i < 8; ++i) wq[lane + 64 * i] = wv8[i];
        }
        stage67(isv ? Tv : Tk, tok0, s0, h * 128 + 64 * hh, st, lane);
        LDS_FENCE();
#pragma unroll 1
        for (int c4 = 0; c4 < 4; ++c4) {
            const int ct = 4 * hh + c4, c = 16 * ct + fr;
            float cwx[4];
#pragma unroll
            for (int r = 0; r < 4; ++r) cwx[r] = wq[(3 - r) * 128 + c];
            bf16x8 xbf[2];
#pragma unroll
            for (int k2 = 0; k2 < 2; ++k2) {
                float xb[8], kd[8];
#pragma unroll
                for (int run = 0; run < 2; ++run) {
                    const int jb = 32 * k2 + 16 * run + 4 * fq;
                    float xx[7];
#pragma unroll
                    for (int d = 0; d < 7; ++d) xx[d] = bf2f(*(const LAS bf16_t*)(st + (jb + d) * 144 + (16 * c4 + fr) * 2));
                    const f32x4 rk4 = *(const LAS f32x4*)(srk + jb), bt4 = *(const LAS f32x4*)(sbt + jb), eg4 = *(const LAS f32x4*)(seg + jb), gc4 = *(const LAS f32x4*)(sgc + jb);
#pragma unroll
                    for (int e = 0; e < 4; ++e) {
                        float ax = 0.f;
#pragma unroll
                        for (int r = 0; r < 4; ++r) ax += cwx[r] * xx[3 + e - r];
                        const float sv = silu_f(ax);
                        if (isv) { xb[4 * run + e] = sv * bt4[e]; kd[4 * run + e] = 0.f; }
                        else { const float kn = sv * rk4[e]; xb[4 * run + e] = kn * bt4[e] * eg4[e]; kd[4 * run + e] = kn * __expf(gl - gc4[e]); }
                    }
                }
                xbf[k2] = pack8(xb);
                if (!isv) kdf[(ct * 2 + k2) * 64 + lane] = __builtin_bit_cast(u32x4, pack8(kd));
            }
#pragma unroll
            for (int mt = 0; mt < 4; ++mt) {
                if (isv) {
                    f32x4 d = {0.f, 0.f, 0.f, 0.f};
                    d = MFMA(Tf[mt][0], xbf[0], d); d = MFMA(Tf[mt][1], xbf[1], d);
                    u32x2 w; w.x = pk(d[0], d[1]); w.y = pk(d[2], d[3]);
                    uf[(ct * 4 + mt) * 64 + lane] = w;
                } else {
                    f32x4 e2 = {0.f, 0.f, 0.f, 0.f};
                    e2 = MFMA(xbf[0], Tf[mt][0], e2); e2 = MFMA(xbf[1], Tf[mt][1], e2);
                    u32x2 w2; w2.x = pk(-e2[0], -e2[1]); w2.y = pk(-e2[2], -e2[3]);
                    ((u32x2*)wf)[((mt * 4 + (ct >> 1)) * 64 + lane) * 2 + (ct & 1)] = w2;
                }
            }
        }
        LDS_FENCE();
    }
}

__device__ __forceinline__ void dn_chunk_phase(KP p, int l, LAS unsigned char* lds) {
    const int wave = fresh_tid() >> 6, G = gridDim.x;
    LAS float* Tm = (LAS float*)(lds + wave * 20480);
    LAS float* sc = (LAS float*)(lds + wave * 20480 + 17408);
    LAS float* wq = (LAS float*)(lds + wave * 20480 + 18432);
    for (int it = blockIdx.x; it < 256; it += G) dn_chunk(p, l, it >> 6, it & 63, wave, Tm, sc, wq);
}

constexpr int SCA_BUF = 34816, SCB_BUF = 24576, SCX_BUF = 6144;
constexpr int SCA_OFF = 0, SCB_OFF = 2 * SCA_BUF, SCX_OFF = SCB_OFF + 3 * SCB_BUF, SC_NCH = (SCA_BUF + SCB_BUF) / 16, SCA_NCH = SCA_BUF / 16;
__device__ __forceinline__ const u32x4* sc_src(unsigned char* ws, int cid, int sl, int i) {
    if (i < 1024) return (const u32x4*)(ws + WS_WF) + (size_t)cid * 1024 + i;
    if (i < 2048) return (const u32x4*)(ws + WS_KDF) + (size_t)cid * 1024 + (i - 1024);
    if (i < 2176) return (const u32x4*)(ws + WS_UF) + (size_t)cid * 1024 + sl * 128 + (i - 2048);
    if (i < 3200) return (const u32x4*)(ws + WS_QDF) + (size_t)cid * 1024 + (i - 2176);
    return (const u32x4*)(ws + WS_ATTN) + (size_t)cid * 512 + (i - 3200);
}
__device__ __forceinline__ void dn_scan_phase(KP p, LAS unsigned char* lds) {
    const int tid = fresh_tid(), lane = tid & 63, wave = __builtin_amdgcn_readfirstlane(tid >> 6), fr = lane & 15, fq = lane >> 4, G = gridDim.x;
    unsigned char* ws = p->ws;
    for (int c = blockIdx.x; c < 256; c += G) {
        const int xcd = c & 7, idx = c >> 3, sl = idx & 7, bh = xcd * 4 + (idx >> 3), b = bh >> 3, h = bh & 7;
        if (wave >= 2) {
            const int pt = tid - 128;
            u32x4 R0[10], R1[10];
#define SC_LOAD(R, step) do { const int st_ = (step) < 63 ? (step) : 63; _Pragma("unroll") for (int r = 0; r < 10; ++r) { int i = pt + 384 * r; i = i < SC_NCH ? i : SC_NCH - 1; R[r] = *sc_src(ws, bh * 64 + st_, sl, i); } } while (0)
#define SC_STORE(R, step) do { LAS unsigned char* wa = lds + SCA_OFF + ((step) & 1) * SCA_BUF; LAS unsigned char* wb = lds + SCB_OFF + ((step) % 3) * SCB_BUF - SCA_NCH * 16; \
        _Pragma("unroll") for (int r = 0; r < 9; ++r) { const int i = pt + 384 * r; LAS unsigned char* d = (i < SCA_NCH) ? wa + i * 16 : wb + i * 16; *(LAS u32x4*)d = R[r]; } \
        if (pt + 384 * 9 < SC_NCH) *(LAS u32x4*)(wb + (pt + 384 * 9) * 16) = R[9]; } while (0)
            SC_LOAD(R0, 0); SC_LOAD(R1, 1);
            SC_STORE(R0, 0);
            SC_LOAD(R0, 2);
            LDS_BARRIER();
#pragma unroll 1
            for (int n = 0; n < 64; n += 2) {
                SC_STORE(R1, n + 1); SC_LOAD(R1, n + 3); LDS_BARRIER();
                SC_STORE(R0, n + 2); SC_LOAD(R0, n + 4); LDS_BARRIER();
            }
            LDS_BARRIER();
#undef SC_LOAD
#undef SC_STORE
        } else if (wave == 0) {
            f32x4 S[8]; bf16x8 Sf[4];
            const float glv = ((const float*)(ws + WS_GL))[bh * 64 + lane];
#pragma unroll
            for (int m = 0; m < 8; ++m) S[m] = (f32x4){0.f, 0.f, 0.f, 0.f};
#pragma unroll
            for (int k = 0; k < 4; ++k) Sf[k] = (bf16x8){0, 0, 0, 0, 0, 0, 0, 0};
#define SC_STEP_A(n) do { \
            const LAS unsigned char* ra = lds + SCA_OFF + ((n) & 1) * SCA_BUF + lane * 16; \
            LAS unsigned char* xw = lds + SCX_OFF + ((n) & 1) * SCX_BUF + lane * 16; \
            _Pragma("unroll") for (int kk = 0; kk < 4; ++kk) *(LAS bf16x8*)(xw + kk * 1024) = Sf[kk]; \
            const float egl = __expf(__shfl(glv, (n))); \
            f32x4 vn[4]; \
            _Pragma("unroll") for (int mt = 0; mt < 4; ++mt) { \
                const u32x2 uu = *(const LAS u32x2*)(lds + SCA_OFF + ((n) & 1) * SCA_BUF + 32768 + (mt * 64 + lane) * 8); \
                f32x4 a = {bflo(uu.x), bfhi(uu.x), bflo(uu.y), bfhi(uu.y)}; \
                _Pragma("unroll") for (int kk = 0; kk < 4; ++kk) a = MFMA(*(const LAS bf16x8*)(ra + (mt * 4 + kk) * 1024), Sf[kk], a); \
                vn[mt] = a; } \
            bf16x8 Vf[2]; Vf[0] = pack44(vn[0], vn[1]); Vf[1] = pack44(vn[2], vn[3]); \
            *(LAS bf16x8*)(xw + 4096) = Vf[0]; *(LAS bf16x8*)(xw + 5120) = Vf[1]; \
            _Pragma("unroll") for (int mt = 0; mt < 8; ++mt) { \
                f32x4 a = S[mt] * egl; \
                a = MFMA(*(const LAS bf16x8*)(ra + 16384 + (mt * 2 + 0) * 1024), Vf[0], a); a = MFMA(*(const LAS bf16x8*)(ra + 16384 + (mt * 2 + 1) * 1024), Vf[1], a); \
                S[mt] = a; } \
            _Pragma("unroll") for (int kk = 0; kk < 4; ++kk) Sf[kk] = pack44(S[2 * kk], S[2 * kk + 1]); \
        } while (0)
            LDS_BARRIER();
#pragma unroll 1
            for (int n = 0; n < 64; n += 2) {
                SC_STEP_A(n); LDS_BARRIER();
                SC_STEP_A(n + 1); LDS_BARRIER();
            }
            LDS_BARRIER();
#undef SC_STEP_A
        } else {
            bf16_t* ob = (bf16_t*)(ws + WS_O);
#define SC_STEP_B(m1) do { \
            const LAS unsigned char* rb = lds + SCB_OFF + ((m1) % 3) * SCB_BUF + lane * 16; \
            const LAS unsigned char* xr = lds + SCX_OFF + ((m1) & 1) * SCX_BUF + lane * 16; \
            bf16x8 Sg[4], Vg[2]; \
            _Pragma("unroll") for (int kk = 0; kk < 4; ++kk) Sg[kk] = *(const LAS bf16x8*)(xr + kk * 1024); \
            Vg[0] = *(const LAS bf16x8*)(xr + 4096); Vg[1] = *(const LAS bf16x8*)(xr + 5120); \
            const int tokb = b * SEQ + 64 * (m1); \
            _Pragma("unroll") for (int mt = 0; mt < 4; ++mt) { \
                f32x4 a = {0.f, 0.f, 0.f, 0.f}; \
                _Pragma("unroll") for (int kk = 0; kk < 4; ++kk) a = MFMA(*(const LAS bf16x8*)(rb + (mt * 4 + kk) * 1024), Sg[kk], a); \
                a = MFMA(*(const LAS bf16x8*)(rb + 16384 + (mt * 2 + 0) * 1024), Vg[0], a); a = MFMA(*(const LAS bf16x8*)(rb + 16384 + (mt * 2 + 1) * 1024), Vg[1], a); \
                _Pragma("unroll") for (int jj = 0; jj < 4; ++jj) ob[(size_t)(tokb + 16 * mt + 4 * fq + jj) * 1024 + h * 128 + sl * 16 + fr] = (bf16_t)(pk(a[jj], 0.f) & 0xffffu); } \
        } while (0)
            LDS_BARRIER();
#pragma unroll 1
            for (int n = 0; n < 64; n += 2) {
                if (n >= 1) SC_STEP_B(n - 1);
                LDS_BARRIER();
                SC_STEP_B(n); LDS_BARRIER();
            }
            SC_STEP_B(63);
            LDS_BARRIER();
#undef SC_STEP_B
        }
    }
}

__device__ __forceinline__ void ya_phase(KP p, int l) {
    const int lane = fresh_tid() & 63, wave = fresh_tid() >> 6, G = gridDim.x;
    const bf16_t* ob = (const bf16_t*)(p->ws + WS_O);
    const bf16_t* Tz = (const bf16_t*)(p->ws + WS_PROJ) + 3 * SPL;
    bf16_t* ya = (bf16_t*)(p->ws + WS_Y);
    float ogv[16];
    { const float* og = p->in[6] + (size_t)l * 128 + (lane & 7) * 16;
#pragma unroll
      for (int e = 0; e < 4; ++e) { const f32x4 t = *(const f32x4*)(og + 4 * e); ogv[4 * e] = t[0]; ogv[4 * e + 1] = t[1]; ogv[4 * e + 2] = t[2]; ogv[4 * e + 3] = t[3]; } }
    const int stride = G * 8;
    for (int row0 = blockIdx.x * 8 + wave; row0 < NTOK; row0 += 4 * stride) {
        u32x4 oa[4], obb[4], za[4], zb[4];
#pragma unroll
        for (int q = 0; q < 4; ++q) {
            const int row = row0 + q * stride;
            if (row < NTOK) { const size_t off = (size_t)row * 1024 + lane * 16;
                oa[q] = *(const u32x4*)(ob + off); obb[q] = *(const u32x4*)(ob + off + 8); za[q] = *(const u32x4*)(Tz + off); zb[q] = *(const u32x4*)(Tz + off + 8); }
        }
#pragma unroll
        for (int q = 0; q < 4; ++q) {
            const int row = row0 + q * stride;
            if (row < NTOK) {
                const unsigned ov[8] = {oa[q].x, oa[q].y, oa[q].z, oa[q].w, obb[q].x, obb[q].y, obb[q].z, obb[q].w}, zv[8] = {za[q].x, za[q].y, za[q].z, za[q].w, zb[q].x, zb[q].y, zb[q].z, zb[q].w};
                float o[16]; float ss = 0.f;
#pragma unroll
                for (int e = 0; e < 8; ++e) { o[2 * e] = bflo(ov[e]); o[2 * e + 1] = bfhi(ov[e]); ss += o[2 * e] * o[2 * e] + o[2 * e + 1] * o[2 * e + 1]; }
                ss += __shfl_xor(ss, 1); ss += __shfl_xor(ss, 2); ss += __shfl_xor(ss, 4);
                const float rstd = rsqrtf(ss * (1.f / 128.f) + 1e-6f);
                unsigned w[8];
#pragma unroll
                for (int e = 0; e < 8; ++e) {
                    const float r0 = o[2 * e] * rstd * ogv[2 * e] * silu_f(bflo(zv[e])), r1 = o[2 * e + 1] * rstd * ogv[2 * e + 1] * silu_f(bfhi(zv[e]));
                    w[e] = pk(r0, r1);
                }
                const size_t offy = (size_t)row * 2048 + lane * 16;
                *(u32x4*)(ya + offy) = (u32x4){w[0], w[1], w[2], w[3]}; *(u32x4*)(ya + offy + 8) = (u32x4){w[4], w[5], w[6], w[7]};
            }
        }
    }
}

__device__ __forceinline__ void ffn_act_phase(KP p, int l) {
    const bf16_t* gu = (const bf16_t*)(p->ws + WS_GU);
    bf16_t* hid = (bf16_t*)(p->ws + WS_HID);
    const float* cw = p->in[17] + (size_t)l * 3 * FF; const float* cb = p->in[18] + (size_t)l * FF;
    const int nitem = (NTOK / 8) * (FF / 8);
    for (int it = blockIdx.x * 512 + fresh_tid(); it < nitem; it += gridDim.x * 512) {
        const int cb8 = it % (FF / 8), tb = it / (FF / 8), c0 = cb8 * 8, t0 = tb * 8;
        float w0[8], w1[8], w2[8], bb[8];
#pragma unroll
        for (int e = 0; e < 8; ++e) { w0[e] = cw[c0 + e]; w1[e] = cw[FF + c0 + e]; w2[e] = cw[2 * FF + c0 + e]; bb[e] = cb[c0 + e]; }
        float g2[8], g1[8];
        const bool first = (t0 % SEQ) == 0;
        {
            u32x4 a = {0u, 0u, 0u, 0u}, b = {0u, 0u, 0u, 0u};
            if (!first) { a = *(const u32x4*)(gu + (size_t)(t0 - 2) * (2 * FF) + c0); b = *(const u32x4*)(gu + (size_t)(t0 - 1) * (2 * FF) + c0); }
            const unsigned av[4] = {a.x, a.y, a.z, a.w}, bv[4] = {b.x, b.y, b.z, b.w};
#pragma unroll
            for (int e = 0; e < 4; ++e) { g2[2 * e] = bflo(av[e]); g2[2 * e + 1] = bfhi(av[e]); g1[2 * e] = bflo(bv[e]); g1[2 * e + 1] = bfhi(bv[e]); }
        }
#pragma unroll
        for (int tt = 0; tt < 8; ++tt) {
            const u32x4 a = *(const u32x4*)(gu + (size_t)(t0 + tt) * (2 * FF) + c0), u = *(const u32x4*)(gu + (size_t)(t0 + tt) * (2 * FF) + FF + c0);
            const unsigned av[4] = {a.x, a.y, a.z, a.w}, uv[4] = {u.x, u.y, u.z, u.w};
            float g0[8], r[8];
#pragma unroll
            for (int e = 0; e < 4; ++e) { g0[2 * e] = bflo(av[e]); g0[2 * e + 1] = bfhi(av[e]); }
#pragma unroll
            for (int e = 0; e < 8; ++e) {
                const float gt = w0[e] * g2[e] + w1[e] * g1[e] + w2[e] * g0[e] + bb[e];
                const float up = (e & 1) ? bfhi(uv[e >> 1]) : bflo(uv[e >> 1]);
                r[e] = silu_f(gt) * up;
                g2[e] = g1[e]; g1[e] = g0[e];
            }
            *(u32x4*)(hid + (size_t)(t0 + tt) * FF + c0) = (u32x4){pk(r[0], r[1]), pk(r[2], r[3]), pk(r[4], r[5]), pk(r[6], r[7])};
        }
    }
}

#define XB_TMO      128
#define XB_XCNT(j)  (256  + 64 * (j))
#define XB_XSUB(j)  (1280 + 64 * (j))
#define XB_XGEN(j)  (2304 + 64 * (j))
#define XB_TOP      3328
#define XB_TOPGEN   3392
#define XCD_BAR_WORDS 3456
#define XB_SPIN_CAP (1u << 20)
__device__ unsigned g_bar[XCD_BAR_WORDS];
__device__ __forceinline__ unsigned xb_ld(unsigned* p)              { return __hip_atomic_load(p, __ATOMIC_RELAXED, __HIP_MEMORY_SCOPE_AGENT); }
__device__ __forceinline__ unsigned xb_add(unsigned* p, unsigned v) { return __hip_atomic_fetch_add(p, v, __ATOMIC_RELAXED, __HIP_MEMORY_SCOPE_AGENT); }
__device__ __forceinline__ unsigned xb_xcc_id() { return (unsigned)__builtin_amdgcn_s_getreg((3 << 11) | 20) & 0xFu; }
#define XB_SPIN(cond, bar) do { unsigned _sp = 0; while (cond) { __builtin_amdgcn_s_sleep(1); \
    if ((++_sp & 255u) == 0u) { if (xb_ld(&(bar)[XB_TMO])) break; if (_sp > XB_SPIN_CAP) { atomicAdd(&(bar)[XB_TMO], 1u); break; } } } } while (0)
struct XB { unsigned x, nloc, nx; };
__device__ __forceinline__ void xb_complete(unsigned* bar, unsigned x, unsigned& nloc, unsigned& nx) {
    const unsigned G = gridDim.x;
    unsigned sum, cnt, mine, sp = 0u;
    for (;;) {
        sum = 0u; cnt = 0u; mine = 0u;
#pragma unroll
        for (unsigned j = 0; j < 16; ++j) { const unsigned c = xb_ld(&bar[XB_XCNT(j)]); sum += c; cnt += (c > 0u) ? 1u : 0u; mine = (j == x) ? c : mine; }
        if (sum == G) break;
        __builtin_amdgcn_s_sleep(1);
        if ((++sp & 255u) == 0u) { if (xb_ld(&bar[XB_TMO])) break; if (sp > XB_SPIN_CAP) { atomicAdd(&bar[XB_TMO], 1u); break; } }
    }
    nloc = mine > 0u ? mine : 1u; nx = cnt > 0u ? cnt : 1u;
}
__device__ __forceinline__ void xcd_barrier(XB& b) {
    asm volatile("s_waitcnt vmcnt(0) lgkmcnt(0)" ::: "memory");
    __syncthreads();
    if (fresh_tid() == 0) {
        unsigned* bar = g_bar;
        __builtin_amdgcn_s_waitcnt(0);
        unsigned nloc = b.nloc, nx = b.nx;
        if (nloc == 0u) { xb_complete(bar, b.x, nloc, nx); b.nloc = nloc; b.nx = nx; }
        const unsigned old = xb_add(&bar[XB_XSUB(b.x)], 1u);
        const unsigned gen = old / nloc;
        if (old + 1u == (gen + 1u) * nloc) {
            __builtin_amdgcn_fence(__ATOMIC_RELEASE, "agent");
            asm volatile("s_waitcnt vmcnt(0)" ::: "memory");
            const unsigned og = xb_add(&bar[XB_TOP], 1u);
            const unsigned tg = og / nx;
            if (og + 1u == (tg + 1u) * nx) xb_add(&bar[XB_TOPGEN], 1u);
            else XB_SPIN(xb_ld(&bar[XB_TOPGEN]) == tg, bar);
            __builtin_amdgcn_fence(__ATOMIC_ACQUIRE, "agent");
            xb_add(&bar[XB_XGEN(b.x)], 1u);
            asm volatile("s_waitcnt vmcnt(0)" ::: "memory");
        } else {
            XB_SPIN(xb_ld(&bar[XB_XGEN(b.x)]) == gen, bar);
            __builtin_amdgcn_fence(__ATOMIC_ACQUIRE, "agent");
            asm volatile("s_waitcnt vmcnt(0)" ::: "memory");
        }
    }
    __syncthreads();
}

constexpr int PH_PER_LAYER = 11, PH_TOTAL = 2 * PH_PER_LAYER + 1;
__global__ void __launch_bounds__(512, 2) mega(Params pa) {
    extern __shared__ __attribute__((aligned(16))) unsigned char lds_raw[];
    LAS unsigned char* lds = (LAS unsigned char*)lds_raw;
    cg::grid_group grid = cg::this_grid();
    const int ph_lo = pa.ph_lo, ph_hi = pa.ph_hi;
#define GSYNC() do { asm volatile("s_waitcnt vmcnt(0) lgkmcnt(0)" ::: "memory"); grid.sync(); if (fresh_tid() < 64) { __builtin_amdgcn_fence(__ATOMIC_ACQUIRE, "agent"); asm volatile("s_waitcnt vmcnt(0)" ::: "memory"); } __syncthreads(); } while (0)
#ifndef DBL_MASK
#define DBL_MASK 0
#endif
#define NREP(bit) (((DBL_MASK) >> (bit)) & 1 ? 2 : 1)
#define RUN(k) (ph_lo <= (k) && (k) < ph_hi)
#define SEAM(k) do { if (RUN(k) && RUN((k) + 1)) { xcd_barrier(xb); } } while (0)
    XB xb; xb.x = xb_xcc_id(); xb.nloc = 0u; xb.nx = 0u;
    if (blockIdx.x == 0) for (int i = fresh_tid(); i < XCD_BAR_WORDS; i += 512) g_bar[i] = 0u;
    GSYNC();
    if (fresh_tid() == 0) (void)xb_add(&g_bar[XB_XCNT(xb.x)], 1u);
#pragma unroll 1
    for (int l0 = 0; l0 < NL; ++l0) {
        const int pb = l0 * PH_PER_LAYER;
        for (int rp = 0; rp < NREP(0); ++rp) { __syncthreads(); if (RUN(pb + 0)) { KP p = get_kp(); const int l = launder_i(l0); xpose_phase(p, l, (LAS float*)lds); __syncthreads(); } }
        for (int rp = 0; rp < NREP(1); ++rp) { __syncthreads(); if (RUN(pb + 0)) { KP p = get_kp(); const int l = launder_i(l0); norm1_phase(p, l, (LAS float*)lds); } }
        SEAM(pb + 0);
        for (int rp = 0; rp < NREP(8); ++rp) { __syncthreads();
        if (RUN(pb + 1)) { KP p = get_kp(); unsigned char* ws = p->ws; const int G = gridDim.x, bid = blockIdx.x;
            pg8::Gemm g{(const bf16_t*)(ws + WS_H), (const bf16_t*)(ws + WS_WIN), NTOK, NIN, DM}; pg8::StaticOrder S; S.init(NTOK, NIN, G, bid);
            pg8::EpiBf16<0> E{(bf16_t*)(ws + WS_PROJ), 1024, nullptr, 1024, SPL};
            pg8::gemm_phase<pg8::EpiBf16<0>, pg8::StaticOrder, false, GEMM_ALIGN, GEMM_SP2>(lds, g, S, E, nullptr);
        }
         }
        SEAM(pb + 1);
        for (int rp = 0; rp < NREP(2); ++rp) { __syncthreads(); if (RUN(pb + 2)) { KP p = get_kp(); const int l = launder_i(l0); gmlp_phase(p, l, lds); __syncthreads(); } }
        for (int rp = 0; rp < NREP(3); ++rp) { __syncthreads(); if (RUN(pb + 2)) { KP p = get_kp(); const int l = launder_i(l0); dn_chunk_phase(p, l, lds); } }
        SEAM(pb + 2);
        for (int rp = 0; rp < NREP(4); ++rp) { __syncthreads(); if (RUN(pb + 3)) { KP p = get_kp(); dn_scan_phase(p, lds); } }
        SEAM(pb + 3);
        for (int rp = 0; rp < NREP(5); ++rp) { __syncthreads(); if (RUN(pb + 4)) { KP p = get_kp(); const int l = launder_i(l0); ya_phase(p, l); } }
        SEAM(pb + 4);
        if (RUN(pb + 5)) { KP p = get_kp(); unsigned char* ws = p->ws; const int G = gridDim.x, bid = blockIdx.x;
            pg8::Gemm g{(const bf16_t*)(ws + WS_Y), (const bf16_t*)(ws + WS_WA), NTOK, DM, 1024, 2048}; PairOrder S; S.S.init(NTOK, DM, G, bid);
            EpiMerge E{(const bf16_t*)(ws + WS_PROJ) + 6 * SPL, (const bf16_t*)(ws + WS_PROJ) + 8 * SPL, (bf16_t*)(ws + WS_MRG)};
            pg8::gemm_phase<EpiMerge, PairOrder, false, GEMM_ALIGN, GEMM_SP2>(lds, g, S, E, nullptr); }
        SEAM(pb + 5);
        if (RUN(pb + 6)) { KP p = get_kp(); unsigned char* ws = p->ws; const int G = gridDim.x, bid = blockIdx.x; const int l = launder_i(l0);
            pg8::Gemm g{(const bf16_t*)(ws + WS_MRG), (const bf16_t*)(ws + WS_WOUT), NTOK, DM, DM}; pg8::StaticOrder S; S.init(NTOK, DM, G, bid);
            EpiRes E{(l == 0) ? p->in[0] : (const float*)p->out, p->out};
            pg8::gemm_phase<EpiRes, pg8::StaticOrder, false, GEMM_ALIGN, GEMM_SP2>(lds, g, S, E, nullptr);
        }
        SEAM(pb + 6);
        for (int rp = 0; rp < NREP(6); ++rp) { __syncthreads(); if (RUN(pb + 7)) { KP p = get_kp(); const int l = launder_i(l0); norm_phase<false>(p->out, p->in[14] + (size_t)l * DM, (bf16_t*)(p->ws + WS_H2), nullptr); } }
        SEAM(pb + 7);
        if (RUN(pb + 8)) { KP p = get_kp(); unsigned char* ws = p->ws; const int G = gridDim.x, bid = blockIdx.x; const int l = launder_i(l0);
            pg8::Gemm g{(const bf16_t*)(ws + WS_H2), (const bf16_t*)(ws + WS_WGU), NTOK, 2 * FF, DM}; pg8::StaticOrder S; S.init(NTOK, 2 * FF, G, bid);
            EpiFfn E{(bf16_t*)(ws + WS_HID), p->in[17] + (size_t)l * 3 * FF, p->in[18] + (size_t)l * FF, (float*)(ws + WS_HALO), (float*)(ws + WS_FIXG), (float*)(ws + WS_FIXU)};
            pg8::gemm_phase<EpiFfn, pg8::StaticOrder, false, GEMM_ALIGN, GEMM_SP2>(lds, g, S, E, nullptr);
        }
        SEAM(pb + 8);
        for (int rp = 0; rp < NREP(7); ++rp) { __syncthreads(); if (RUN(pb + 9)) { KP p = get_kp(); const int l = launder_i(l0); ffn_fix_phase(p, l); } }
        SEAM(pb + 9);
        if (RUN(pb + 10)) { KP p = get_kp(); unsigned char* ws = p->ws; const int G = gridDim.x, bid = blockIdx.x;
            pg8::Gemm g{(const bf16_t*)(ws + WS_HID), (const bf16_t*)(ws + WS_WD), NTOK, DM, FF}; pg8::StaticOrder S; S.init(NTOK, DM, G, bid);
            EpiRes E{(const float*)p->out, p->out};
            pg8::gemm_phase<EpiRes, pg8::StaticOrder, false, GEMM_ALIGN, GEMM_SP2>(lds, g, S, E, nullptr);
        }
        SEAM(pb + 10);
    }
    if (pa.dbg) { KP p = get_kp(); unsigned char* ws = p->ws; float* out = p->out;
        GSYNC();
        const size_t NH = (size_t)NTOK * 1024;
        for (size_t i = (size_t)blockIdx.x * 512 + fresh_tid(); i < NH; i += (size_t)gridDim.x * 512) {
            float a = 0.f, b = 0.f;
            if (pa.dbg == 1) { a = bf2f(((const bf16_t*)(ws + WS_WF))[i]) + bf2f(((const bf16_t*)(ws + WS_KDF))[i]); b = bf2f(((const bf16_t*)(ws + WS_QDF))[i]) + bf2f(((const bf16_t*)(ws + WS_UF))[i]); }
            if (pa.dbg == 2) { a = (i < NH / 2) ? bf2f(((const bf16_t*)(ws + WS_ATTN))[i]) : ((i - NH / 2 < 2048) ? ((const float*)(ws + WS_GL))[i - NH / 2] : 0.f); b = (i < 262144) ? ((const float*)(ws + WS_BETA))[i] + ((const float*)(ws + WS_G))[i] : 0.f; }
            if (pa.dbg == 3) { a = bf2f(((const bf16_t*)(ws + WS_O))[i]); b = bf2f(((const bf16_t*)(ws + WS_Y))[i]); }
            if (!(fabsf(a) < 1e30f)) a = 12345.f; if (!(fabsf(b) < 1e30f)) b = 12345.f;
            out[i] = a; out[NH + i] = b;
        }
        return; }
    if (RUN(PH_TOTAL - 1)) { KP p = get_kp(); norm_phase<true>(p->out, p->in[20], nullptr, p->out); }
#undef RUN
#undef SEAM
}
}

#ifndef DBG_MODE
#define DBG_MODE 0
#define DBG_HI mk::PH_TOTAL
#endif
extern "C" void kernel_launch(void* const* d_in, const int* in_sizes, int n_in, void* d_out, int out_size, void* d_ws, size_t ws_size, hipStream_t stream) {
    static int grid = 0;
    if (grid == 0) {
        if (n_in != 21 || ws_size < mk::WS_END) { fprintf(stderr, "kernel_launch: need 21 inputs and >= %zu bytes of workspace; got %d, %zu\n", (size_t)mk::WS_END, n_in, ws_size); grid = -1; return; }
        int dev = 0, cus = 0, per_cu = 0;
        hipGetDevice(&dev);
        hipDeviceGetAttribute(&cus, hipDeviceAttributeMultiprocessorCount, dev);
        if (hipFuncSetAttribute((const void*)mk::mega, hipFuncAttributeMaxDynamicSharedMemorySize, mk::LDS_BYTES) != hipSuccess) { fprintf(stderr, "kernel_launch: hipFuncSetAttribute failed\n"); grid = -1; return; }
        if (hipOccupancyMaxActiveBlocksPerMultiprocessor(&per_cu, (const void*)mk::mega, 512, mk::LDS_BYTES) != hipSuccess || per_cu < 1) { fprintf(stderr, "kernel_launch: occupancy query says %d\n", per_cu); per_cu = 1; }
        (void)hipGetLastError();
        grid = cus * 1;
    }
    if (grid < 0) return;
    mk::Params p{};
    for (int i = 0; i < 21; ++i) p.in[i] = (const float*)d_in[i];
    p.out = (float*)d_out; p.ws = (unsigned char*)d_ws; p.ph_lo = 0; p.ph_hi = DBG_HI; p.dbg = DBG_MODE;
    void* args[] = {&p};
    hipError_t e = hipLaunchCooperativeKernel((const void*)mk::mega, dim3(grid), dim3(512), args, mk::LDS_BYTES, stream);
    if (e != hipSuccess) fprintf(stderr, "cooperative launch failed: %s (grid %d)\n", hipGetErrorString(e), grid);
}
```
